# Optimizing an MI355X kernel written in HIP

```python
import math
import jax
import jax.numpy as jnp
from jax import lax
import numpy as np

D_MODEL = 4096
BATCH = 4
SEQ = 4096
DEPTH = 2

MIX_WIDTH = D_MODEL
S5_WIDTH = MIX_WIDTH // 4
SGU_WIDTH = MIX_WIDTH // 4
HG_WIDTH = MIX_WIDTH - S5_WIDTH - SGU_WIDTH
S5_GROUP_CH = 16
S5_GROUPS = S5_WIDTH // S5_GROUP_CH
S5_STATE = 64
SGU_CHUNK = 128
SGU_HEAD_DIM = 128
SGU_HEADS = SGU_WIDTH // SGU_HEAD_DIM
HG_HEAD_DIM = 128
HG_HEADS = HG_WIDTH // HG_HEAD_DIM
HG_CHUNK = 64
D_FF = -(-8 * D_MODEL // (3 * 256)) * 256
PLE_DIM = 256
LN_EPS = 1e-5
RMS_EPS = 1e-6
PROJ_WIDTH = S5_WIDTH + 2 * SGU_WIDTH + 4 * HG_WIDTH
IN_SPLITS = (S5_WIDTH,
             S5_WIDTH + SGU_WIDTH,
             S5_WIDTH + 2 * SGU_WIDTH,
             S5_WIDTH + 2 * SGU_WIDTH + HG_WIDTH,
             S5_WIDTH + 2 * SGU_WIDTH + 2 * HG_WIDTH,
             S5_WIDTH + 2 * SGU_WIDTH + 3 * HG_WIDTH)

kernel_name = "hybrid_s5_sgu_hgrn2_deepnorm"


def layer_norm(x, w, b):
    xf = x.astype(jnp.float32)
    mu = jnp.mean(xf, axis=-1, keepdims=True)
    var = jnp.mean(jnp.square(xf - mu), axis=-1, keepdims=True)
    return ((xf - mu) * lax.rsqrt(var + LN_EPS)).astype(x.dtype) * w + b


def rms_norm(x, w):
    xf = x.astype(jnp.float32)
    y = xf * lax.rsqrt(jnp.mean(jnp.square(xf), axis=-1, keepdims=True) + RMS_EPS)
    return y.astype(x.dtype) * w


def _complex_linear_combine(e1, e2):
    a1r, a1i, b1r, b1i = e1
    a2r, a2i, b2r, b2i = e2
    return (a2r * a1r - a2i * a1i,
            a2r * a1i + a2i * a1r,
            a2r * b1r - a2i * b1i + b2r,
            a2r * b1i + a2i * b1r + b2i)


def s5_mixer(u, lam_re, lam_im, log_step, b_re, b_im, c_re, c_im, d, w_glu):
    bsz, seq, _ = u.shape
    uf = u.astype(jnp.float32).reshape(bsz, seq, S5_GROUPS, S5_GROUP_CH)
    lr = jnp.minimum(lam_re.astype(jnp.float32), -1e-4)
    li = lam_im.astype(jnp.float32)
    dt = jnp.exp(log_step.astype(jnp.float32))[:, None]
    mag = jnp.exp(lr * dt)
    ab_re = mag * jnp.cos(li * dt)
    ab_im = mag * jnp.sin(li * dt)
    den = lr * lr + li * li
    nr = ab_re - 1.0
    g_re = (nr * lr + ab_im * li) / den
    g_im = (ab_im * lr - nr * li) / den
    br = b_re.astype(jnp.float32)
    bi = b_im.astype(jnp.float32)
    bb_re = g_re[..., None] * br - g_im[..., None] * bi
    bb_im = g_re[..., None] * bi + g_im[..., None] * br
    bu_re = jnp.einsum('gnc,blgc->lbgn', bb_re, uf)
    bu_im = jnp.einsum('gnc,blgc->lbgn', bb_im, uf)
    a_re = jnp.broadcast_to(ab_re[None, None], (seq, 1, S5_GROUPS, S5_STATE))
    a_im = jnp.broadcast_to(ab_im[None, None], (seq, 1, S5_GROUPS, S5_STATE))
    _, _, s_re, s_im = lax.associative_scan(_complex_linear_combine,
                                            (a_re, a_im, bu_re, bu_im), axis=0)
    y = (jnp.einsum('gcn,lbgn->blgc', c_re.astype(jnp.float32), s_re)
         - jnp.einsum('gcn,lbgn->blgc', c_im.astype(jnp.float32), s_im)
         + d.astype(jnp.float32).reshape(S5_GROUPS, S5_GROUP_CH) * uf)
    z = jax.nn.gelu(y.reshape(bsz, seq, S5_WIDTH)).astype(u.dtype)
    return z * jax.nn.sigmoid(z @ w_glu)


def sgu_mixer(u, v, ln_w, ln_b, w_s, b_s):
    bsz, seq, _ = u.shape
    u = jax.nn.gelu(u)
    v = layer_norm(jax.nn.gelu(v), ln_w, ln_b)
    vc = v.reshape(bsz, seq // SGU_CHUNK, SGU_CHUNK, SGU_HEADS, SGU_HEAD_DIM)
    causal = jnp.tril(jnp.ones((SGU_CHUNK, SGU_CHUNK), dtype=bool))
    ws = jnp.where(causal[None], w_s, jnp.zeros_like(w_s))
    z = jnp.einsum('hts,bcshd->bcthd', ws, vc) + b_s.T[None, None, :, :, None]
    return u * z.reshape(bsz, seq, SGU_WIDTH)


def gated_recurrence_chunked(q, k, v, log_f):
    bsz, seq, nh, dk = q.shape
    dv = v.shape[-1]
    n_chunks = seq // HG_CHUNK

    def chunks(t):
        return t.reshape(bsz, n_chunks, HG_CHUNK, nh, t.shape[-1]).transpose(1, 0, 3, 2, 4)

    qc, kc, vc = chunks(q), chunks(k), chunks(v)
    bc = jnp.cumsum(chunks(log_f), axis=3)
    causal = jnp.tril(jnp.ones((HG_CHUNK, HG_CHUNK), dtype=bool))[:, :, None]

    def step(state, inp):
        q_, k_, v_, b_ = inp
        o_inter = jnp.einsum('bhtk,bhkv->bhtv', q_ * jnp.exp(b_), state)
        rel = jnp.where(causal, b_[:, :, :, None, :] - b_[:, :, None, :, :], -jnp.inf)
        scores = jnp.einsum('bhtsk,bhsk->bhts', q_[:, :, :, None, :] * jnp.exp(rel), k_)
        o_intra = jnp.einsum('bhts,bhsv->bhtv', scores, v_)
        b_end = b_[:, :, -1:, :]
        state = (jnp.exp(b_end[:, :, 0, :, None]) * state
                 + jnp.einsum('bhsk,bhsv->bhkv', k_ * jnp.exp(b_end - b_), v_))
        return state, o_inter + o_intra

    s0 = jnp.zeros((bsz, nh, dk, dv), q.dtype)
    _, o = lax.scan(step, s0, (qc, kc, vc, bc))
    return o.transpose(1, 0, 3, 2, 4).reshape(bsz, seq, nh, dv)


def hgrn2_mixer(q, f, i, g, lb, norm_w):
    bsz, seq, _ = q.shape

    def heads(t):
        return t.astype(jnp.float32).reshape(bsz, seq, HG_HEADS, HG_HEAD_DIM)

    qh = jax.nn.silu(heads(q))
    fr = heads(f)
    vh = heads(i)
    lbh = lb.astype(jnp.float32).reshape(HG_HEADS, HG_HEAD_DIM)
    log_f = jnp.logaddexp(jnp.log(lbh), jnp.log1p(-lbh) + jax.nn.log_sigmoid(fr))
    kh = (1.0 - lbh) * jax.nn.sigmoid(-fr)
    o = gated_recurrence_chunked(qh, kh, vh, log_f)
    o = rms_norm(o, norm_w.astype(jnp.float32)) * jax.nn.silu(heads(g))
    return o.reshape(bsz, seq, HG_WIDTH).astype(q.dtype)


def setup_inputs(seed: int = 0) -> dict:
    key = jax.random.key(seed)
    ks = iter(jax.random.split(key, 40))
    f32 = jnp.float32

    def nrm(shape, scale=1.0):
        return scale * jax.random.normal(next(ks), shape, f32)

    def gain(shape):
        return 1.0 + 0.01 * jax.random.normal(next(ks), shape, f32)

    beta = (8.0 * DEPTH) ** -0.25
    n_idx = jnp.arange(S5_STATE, dtype=f32)
    return {
        "x": nrm((BATCH, SEQ, D_MODEL)),
        "p": nrm((DEPTH, BATCH, SEQ, PLE_DIM)),
        "w_in": nrm((DEPTH, D_MODEL, PROJ_WIDTH), D_MODEL ** -0.5),
        "s5_lam_re": -0.5 + nrm((DEPTH, S5_GROUPS, S5_STATE), 0.01),
        "s5_lam_im": math.pi * n_idx + nrm((DEPTH, S5_GROUPS, S5_STATE), 0.01),
        "s5_log_step": jax.random.uniform(next(ks), (DEPTH, S5_GROUPS), f32,
                                          math.log(1e-3), math.log(1e-1)),
        "s5_b_re": nrm((DEPTH, S5_GROUPS, S5_STATE, S5_GROUP_CH), (2.0 * S5_GROUP_CH) ** -0.5),
        "s5_b_im": nrm((DEPTH, S5_GROUPS, S5_STATE, S5_GROUP_CH), (2.0 * S5_GROUP_CH) ** -0.5),
        "s5_c_re": nrm((DEPTH, S5_GROUPS, S5_GROUP_CH, S5_STATE), (2.0 * S5_STATE) ** -0.5),
        "s5_c_im": nrm((DEPTH, S5_GROUPS, S5_GROUP_CH, S5_STATE), (2.0 * S5_STATE) ** -0.5),
        "s5_d": nrm((DEPTH, S5_WIDTH)),
        "s5_w_glu": nrm((DEPTH, S5_WIDTH, S5_WIDTH), S5_WIDTH ** -0.5),
        "sgu_ln_w": gain((DEPTH, SGU_WIDTH)),
        "sgu_ln_b": nrm((DEPTH, SGU_WIDTH), 0.01),
        "sgu_w": nrm((DEPTH, SGU_HEADS, SGU_CHUNK, SGU_CHUNK), SGU_CHUNK ** -0.5),
        "sgu_b": gain((DEPTH, SGU_HEADS, SGU_CHUNK)),
        "hg_lb_logits": nrm((DEPTH, HG_WIDTH), 0.1),
        "hg_norm_w": gain((DEPTH, HG_HEAD_DIM)),
        "norm_a_w": gain((DEPTH, S5_WIDTH)),
        "norm_b_w": gain((DEPTH, SGU_WIDTH)),
        "w_out": nrm((DEPTH, MIX_WIDTH, D_MODEL), beta * MIX_WIDTH ** -0.5),
        "ln1_w": gain((DEPTH, D_MODEL)),
        "ln1_b": nrm((DEPTH, D_MODEL), 0.01),
        "w_ffn_in": nrm((DEPTH, D_MODEL, 2 * D_FF), D_MODEL ** -0.5),
        "w_ffn_out": nrm((DEPTH, D_FF, D_MODEL), beta * D_FF ** -0.5),
        "ln2_w": gain((DEPTH, D_MODEL)),
        "ln2_b": nrm((DEPTH, D_MODEL), 0.01),
        "w_ple_in": nrm((DEPTH, PLE_DIM, D_MODEL), beta * PLE_DIM ** -0.5),
        "w_ple_gate": nrm((DEPTH, D_MODEL, D_MODEL), D_MODEL ** -0.5),
        "ln3_w": gain((DEPTH, D_MODEL)),
        "ln3_b": nrm((DEPTH, D_MODEL), 0.01),
    }


def reference(x, p, w_in, s5_lam_re, s5_lam_im, s5_log_step, s5_b_re, s5_b_im, s5_c_re, s5_c_im,
              s5_d, s5_w_glu, sgu_ln_w, sgu_ln_b, sgu_w, sgu_b, hg_lb_logits, hg_norm_w,
              norm_a_w, norm_b_w, w_out, ln1_w, ln1_b, w_ffn_in, w_ffn_out, ln2_w, ln2_b,
              w_ple_in, w_ple_gate, ln3_w, ln3_b):
    alpha = (2.0 * DEPTH) ** 0.25
    lbs = jnp.cumsum(jax.nn.softmax(hg_lb_logits.astype(jnp.float32), axis=0), axis=0)
    lbs = lbs - lbs[0:1]
    h = x
    for l in range(DEPTH):
        proj = h @ w_in[l]
        xa, u, v, q, f, ig, g = jnp.split(proj, IN_SPLITS, axis=-1)
        ya = rms_norm(s5_mixer(xa, s5_lam_re[l], s5_lam_im[l], s5_log_step[l], s5_b_re[l],
                               s5_b_im[l], s5_c_re[l], s5_c_im[l], s5_d[l], s5_w_glu[l]),
                      norm_a_w[l])
        yb = rms_norm(sgu_mixer(u, v, sgu_ln_w[l], sgu_ln_b[l], sgu_w[l], sgu_b[l]), norm_b_w[l])
        yc = hgrn2_mixer(q, f, ig, g, lbs[l], hg_norm_w[l])
        mix = jnp.concatenate([ya, yb, yc], axis=-1) @ w_out[l]
        h = layer_norm(alpha * h + mix, ln1_w[l], ln1_b[l])
        gate, up = jnp.split(h @ w_ffn_in[l], 2, axis=-1)
        h = layer_norm(alpha * h + (jax.nn.silu(gate) * up) @ w_ffn_out[l], ln2_w[l], ln2_b[l])
        ple = (p[l] @ w_ple_in[l]) * jax.nn.sigmoid(h @ w_ple_gate[l])
        h = layer_norm(alpha * h + ple, ln3_w[l], ln3_b[l])
    return h
```

```cpp
#include <hip/hip_runtime.h>
#include <cstdio>
#include <cstdint>
namespace pg8 {
#define PG8_LAS __attribute__((address_space(3)))
typedef unsigned short bf16_t;
typedef short bf16x8 __attribute__((ext_vector_type(8)));
typedef float f32x4 __attribute__((ext_vector_type(4)));
typedef unsigned u32x4 __attribute__((ext_vector_type(4)));
constexpr int BM = 256, BK = 64, HALF = 128, HTB = HALF * BK * 2  , STAGE_BYTES = 8 * HTB, NXCD = 8, WGM = 8;

__host__ __device__ __forceinline__ int lds_byte(int r, int c) { const int st = (r >> 4) * 2 + (c >> 5), rr = r & 15, cc = c & 31, ob = rr * 64 + cc * 2; return st * 1024 + (ob ^ (((ob >> 9) & 1) << 5)); }
__host__ __device__ __forceinline__ void stage_rc(int b, int& R, int& C) { const int st = b / 1024, sb = b % 1024, swz = sb ^ (((sb >> 9) & 1) << 5); R = (st >> 1) * 16 + swz / 64; C = (st & 1) * 32 + (swz % 64) / 2; }
__host__ __device__ __forceinline__ int perm32(int rho) { const int n = rho >> 4, i = rho & 15; return 8 * (i >> 2) + 4 * n + (i & 3); }

struct Unit { int pm, pn; };
struct Gemm { const bf16_t* A; const bf16_t* Bt; int M, N, K; };

struct StaticOrder {
    int nM, nN, nwg, G, c;
    __host__ __device__ void init(int M, int N, int G_, int c_) { nM = M / BM; nN = N / BM; nwg = nM * nN; G = G_; c = c_; }
    __host__ __device__ bool next(int i, Unit& u) const {
        const long L = (long)i * G + c; if (L >= nwg) return false;
        int wgid = (int)L; { const int q = nwg / NXCD, r = nwg % NXCD, xcd = wgid % NXCD, off = wgid / NXCD; wgid = (xcd < r ? xcd * (q + 1) : r * (q + 1) + (xcd - r) * q) + off; }
        const int nig = WGM * nN, gid = wgid / nig, fm = gid * WGM, gsz = (nM - fm) < WGM ? (nM - fm) : WGM;
        u.pm = fm + ((wgid % nig) % gsz); u.pn = (wgid % nig) / gsz; return true;
    }
    __device__ __forceinline__ void a_ready(const Unit&) const {}
    __device__ __forceinline__ void done(const Unit&) const {}
};
__device__ __forceinline__ unsigned cvt_pk_bf16(float lo, float hi) { unsigned r; asm volatile("v_cvt_pk_bf16_f32 %0, %1, %2" : "=v"(r) : "v"(lo), "v"(hi)); return r; }
typedef float f32x2 __attribute__((ext_vector_type(2)));
__device__ __forceinline__ float sigm(float x) { return __builtin_amdgcn_rcpf(1.0f + __builtin_amdgcn_exp2f(-1.4426950408889634f * x)); }
struct EpiBf16Plain {
    static constexpr bool PERM = true, AFTER_DRAIN = false;
    bf16_t* O; int ldc;
    __device__ __forceinline__ void operator()(const f32x4 (&acc)[2][2][4][2], const Unit& u, int wr, int wc, int fr, int fq) const {
        const int row0 = u.pm * BM + wr * 64 + fr, col0 = u.pn * BM + wc * 32 + 8 * fq;
#pragma unroll
        for (int ai = 0; ai < 2; ++ai)
#pragma unroll
            for (int m = 0; m < 4; ++m) { bf16_t* rowp = O + (size_t)(row0 + ai * HALF + m * 16) * ldc + col0;
#pragma unroll
                for (int bj = 0; bj < 2; ++bj) { const f32x4 v0 = acc[ai][bj][m][0], v1 = acc[ai][bj][m][1];
                    u32x4 w; w.x = cvt_pk_bf16(v0[0], v0[1]); w.y = cvt_pk_bf16(v0[2], v0[3]); w.z = cvt_pk_bf16(v1[0], v1[1]); w.w = cvt_pk_bf16(v1[2], v1[3]);
                    *(u32x4*)(rowp + bj * HALF) = w; } }
    }
};
struct EpiSwiGLU {
    static constexpr bool PERM = true, AFTER_DRAIN = false;
    bf16_t* O; int ldc;
    __device__ __forceinline__ void operator()(const f32x4 (&acc)[2][2][4][2], const Unit& u, int wr, int wc, int fr, int fq) const {
        const int row0 = u.pm * BM + wr * 64 + fr, col0 = u.pn * HALF + wc * 32 + 8 * fq;
#pragma unroll
        for (int ai = 0; ai < 2; ++ai)
#pragma unroll
            for (int m = 0; m < 4; ++m) { bf16_t* rowp = O + (size_t)(row0 + ai * HALF + m * 16) * ldc + col0;
                const f32x4 g0 = acc[ai][0][m][0], g1 = acc[ai][0][m][1], u0 = acc[ai][1][m][0], u1 = acc[ai][1][m][1];
                f32x4 r0, r1;
#pragma unroll
                for (int j = 0; j < 4; ++j) { r0[j] = g0[j] * sigm(g0[j]) * u0[j]; r1[j] = g1[j] * sigm(g1[j]) * u1[j]; }
                u32x4 w; w.x = cvt_pk_bf16(r0[0], r0[1]); w.y = cvt_pk_bf16(r0[2], r0[3]); w.z = cvt_pk_bf16(r1[0], r1[1]); w.w = cvt_pk_bf16(r1[2], r1[3]);
                *(u32x4*)rowp = w; }
    }
};
struct EpiResF32 {
    static constexpr bool PERM = false, AFTER_DRAIN = false;
    const float* res; float* out; int ldc; float alpha;
    __device__ __forceinline__ void operator()(const f32x4 (&acc)[2][2][4][2], const Unit& u, int wr, int wc, int fr, int fq) const {
        const int row0 = u.pm * BM + wr * 64 + fr, col0 = u.pn * BM + wc * 32 + 4 * fq;
#pragma unroll
        for (int ai = 0; ai < 2; ++ai)
#pragma unroll
            for (int m = 0; m < 4; ++m) { const size_t off = (size_t)(row0 + ai * HALF + m * 16) * ldc + col0;
#pragma unroll
                for (int bj = 0; bj < 2; ++bj)
#pragma unroll
                    for (int n = 0; n < 2; ++n) { const f32x4 r = *(const f32x4*)(res + off + bj * HALF + n * 16); *(f32x4*)(out + off + bj * HALF + n * 16) = r * alpha + acc[ai][bj][m][n]; }
                asm volatile("" ::: "memory"); }
    }
};
struct EpiGlu {
    static constexpr bool PERM = true, AFTER_DRAIN = false;
    const bf16_t* Z; float* out; int ldc;
    __device__ __forceinline__ void operator()(const f32x4 (&acc)[2][2][4][2], const Unit& u, int wr, int wc, int fr, int fq) const {
        const int row0 = u.pm * BM + wr * 64 + fr, col0 = u.pn * BM + wc * 32 + 8 * fq;
#pragma unroll
        for (int ai = 0; ai < 2; ++ai)
#pragma unroll
            for (int m = 0; m < 4; ++m) { const size_t off = (size_t)(row0 + ai * HALF + m * 16) * ldc + col0;
#pragma unroll
                for (int bj = 0; bj < 2; ++bj) { const u32x4 zw = *(const u32x4*)(Z + off + bj * HALF); const f32x4 v0 = acc[ai][bj][m][0], v1 = acc[ai][bj][m][1];
                    f32x4 o0, o1;
                    o0[0] = __uint_as_float(zw.x << 16) * sigm(v0[0]); o0[1] = __uint_as_float(zw.x & 0xffff0000u) * sigm(v0[1]);
                    o0[2] = __uint_as_float(zw.y << 16) * sigm(v0[2]); o0[3] = __uint_as_float(zw.y & 0xffff0000u) * sigm(v0[3]);
                    o1[0] = __uint_as_float(zw.z << 16) * sigm(v1[0]); o1[1] = __uint_as_float(zw.z & 0xffff0000u) * sigm(v1[1]);
                    o1[2] = __uint_as_float(zw.w << 16) * sigm(v1[2]); o1[3] = __uint_as_float(zw.w & 0xffff0000u) * sigm(v1[3]);
                    *(f32x4*)(out + off + bj * HALF) = o0; *(f32x4*)(out + off + bj * HALF + 4) = o1; } }
    }
};
struct EpiPle {
    static constexpr bool PERM = false, AFTER_DRAIN = false;
    const float* res; const bf16_t* PI; float* out; int ldc; float alpha;
    __device__ __forceinline__ void operator()(const f32x4 (&acc)[2][2][4][2], const Unit& u, int wr, int wc, int fr, int fq) const {
        typedef unsigned u32x2 __attribute__((ext_vector_type(2)));
        const int row0 = u.pm * BM + wr * 64 + fr, col0 = u.pn * BM + wc * 32 + 4 * fq;
#pragma unroll
        for (int ai = 0; ai < 2; ++ai)
#pragma unroll
            for (int m = 0; m < 4; ++m) { const size_t off = (size_t)(row0 + ai * HALF + m * 16) * ldc + col0;
#pragma unroll
                for (int bj = 0; bj < 2; ++bj)
#pragma unroll
                    for (int n = 0; n < 2; ++n) { const size_t o2 = off + bj * HALF + n * 16; const f32x4 r = *(const f32x4*)(res + o2); const u32x2 pw = *(const u32x2*)(PI + o2); const f32x4 a = acc[ai][bj][m][n];
                        f32x4 o; o[0] = r[0] * alpha + __uint_as_float(pw.x << 16) * sigm(a[0]); o[1] = r[1] * alpha + __uint_as_float(pw.x & 0xffff0000u) * sigm(a[1]);
                        o[2] = r[2] * alpha + __uint_as_float(pw.y << 16) * sigm(a[2]); o[3] = r[3] * alpha + __uint_as_float(pw.y & 0xffff0000u) * sigm(a[3]);
                        *(f32x4*)(out + o2) = o; }
                asm volatile("" ::: "memory"); }
    }
};
template <class Epi, class Sched, bool ALIGN_EPI = false, bool SP2 = false>
__device__ __forceinline__ void gemm_phase(PG8_LAS unsigned char* lds, const Gemm g, const Sched& S, const Epi& E) {
    int tid_ = threadIdx.x; asm volatile("" : "+v"(tid_));
    const int tid = tid_, wid = __builtin_amdgcn_readfirstlane(tid >> 6), lane = tid & 63, wr = wid >> 2, wc = wid & 3, fr = lane & 15, fq = lane >> 4;
    const int K = g.K, nt = K / BK;
    unsigned voffA[2], voffB[2];
#pragma unroll
    for (int i = 0; i < 2; ++i) { int R, C; stage_rc(tid * 16 + i * 8192, R, C); const int Rb = Epi::PERM ? ((R & ~31) + perm32(R & 31)) : R;
        voffA[i] = (unsigned)(R * K + C) * 2u; voffB[i] = (unsigned)(Rb * K + C) * 2u; }
    const size_t kstep = (size_t)(BK * 2);
    const size_t hstep = (size_t)HALF * K * 2;
    const size_t tstep = 2 * hstep;
    const unsigned ldsw = (unsigned)wid * 1024u;
    const int aoff = lds_byte(wr * 64 + fr, fq * 8), boff = lds_byte(wc * 32 + fr, fq * 8);
#define PG8_SA(b, h) (((b) * 2 + (h)) * HTB)
#define PG8_SB(b, h) ((4 + (b) * 2 + (h)) * HTB)
#define PG8_STAGE(bufoff, gbase, voff) do { _Pragma("unroll") for (int _i = 0; _i < 2; ++_i) \
        __builtin_amdgcn_global_load_lds((const unsigned*)((const char*)(gbase) + (voff)[_i]), (PG8_LAS unsigned*)(lds + (bufoff) + ldsw + _i * 8192), 16, 0, 0); } while (0)
#define PG8_LDA(dst, b, h) do { _Pragma("unroll") for (int m = 0; m < 4; ++m) _Pragma("unroll") for (int k = 0; k < 2; ++k) dst[m][k] = *(const PG8_LAS bf16x8*)(lds + PG8_SA(b, h) + aoff + m * 2048 + k * 1024); } while (0)
#define PG8_LDB(dst, b, h) do { _Pragma("unroll") for (int n = 0; n < 2; ++n) _Pragma("unroll") for (int k = 0; k < 2; ++k) dst[n][k] = *(const PG8_LAS bf16x8*)(lds + PG8_SB(b, h) + boff + n * 2048 + k * 1024); } while (0)
#define PG8_MMA(ai, bj, At, Bt) do { __builtin_amdgcn_s_setprio(1); _Pragma("unroll") for (int m = 0; m < 4; ++m) _Pragma("unroll") for (int n = 0; n < 2; ++n) _Pragma("unroll") for (int k = 0; k < 2; ++k) \
        acc[ai][bj][m][n] = __builtin_amdgcn_mfma_f32_16x16x32_bf16(Bt[n][k], At[m][k], acc[ai][bj][m][n], 0, 0, 0); __builtin_amdgcn_s_setprio(0); } while (0)
#define PG8_WAIT_V(n) asm volatile("s_waitcnt vmcnt(" #n ")" ::: "memory")
#define PG8_WAIT_L(n) asm volatile("s_waitcnt lgkmcnt(" #n ")" ::: "memory")
#define PG8_BAR __builtin_amdgcn_s_barrier()
#define PG8_SCHED __builtin_amdgcn_sched_barrier(0)
    Unit cur, nxt; int ui = 0;
    if (!S.next(0, cur)) return;
    f32x4 acc[2][2][4][2];
#pragma unroll
    for (int a = 0; a < 2; ++a)
#pragma unroll
        for (int b = 0; b < 2; ++b)
#pragma unroll
            for (int m = 0; m < 4; ++m)
#pragma unroll
                for (int n = 0; n < 2; ++n) acc[a][b][m][n] = (f32x4){0.f, 0.f, 0.f, 0.f};
    bf16x8 At[4][2], B0[2][2], B1[2][2];
    const char* cA = (const char*)g.A + (size_t)cur.pm * tstep; const char* cB = (const char*)g.Bt + (size_t)cur.pn * tstep;
    S.a_ready(cur);
    if constexpr (SP2) {
        PG8_STAGE(PG8_SB(0, 0), cB, voffB); PG8_STAGE(PG8_SB(0, 1), cB + hstep, voffB); PG8_STAGE(PG8_SA(0, 0), cA, voffA); PG8_STAGE(PG8_SA(0, 1), cA + hstep, voffA);
        if (wr == 1) PG8_BAR;
        PG8_WAIT_V(2); PG8_BAR;
        PG8_STAGE(PG8_SB(1, 0), cB + kstep, voffB); PG8_STAGE(PG8_SA(1, 0), cA + kstep, voffA); PG8_STAGE(PG8_SB(1, 1), cB + hstep + kstep, voffB);
        PG8_WAIT_V(6); PG8_BAR;
    } else {
        PG8_STAGE(PG8_SB(0, 0), cB, voffB); PG8_STAGE(PG8_SA(0, 0), cA, voffA); PG8_STAGE(PG8_SB(0, 1), cB + hstep, voffB); PG8_STAGE(PG8_SA(0, 1), cA + hstep, voffA);
        if (wr == 1) PG8_BAR;
        PG8_WAIT_V(4); PG8_BAR;
        PG8_STAGE(PG8_SB(1, 0), cB + kstep, voffB); PG8_STAGE(PG8_SA(1, 0), cA + kstep, voffA); PG8_STAGE(PG8_SB(1, 1), cB + hstep + kstep, voffB);
        PG8_WAIT_V(6); PG8_BAR;
    }
    for (;;) {
        const bool has_next = S.next(ui + 1, nxt);
        const char* nA = has_next ? (const char*)g.A + (size_t)nxt.pm * tstep : cA; const char* nB = has_next ? (const char*)g.Bt + (size_t)nxt.pn * tstep : cB;
        for (int t = 0; t < nt; t += 2) {
            const bool last = (t == nt - 2);
            const char* a1 = cA + (size_t)(t + 1) * kstep;
            const char* a2 = last ? nA : cA + (size_t)(t + 2) * kstep; const char* b2 = last ? nB : cB + (size_t)(t + 2) * kstep;
            const char* a3 = a2 + kstep; const char* b3 = b2 + kstep;
            if (last && has_next) S.a_ready(nxt);
            if constexpr (SP2) {
            PG8_LDB(B0, 0, 0); PG8_LDB(B1, 0, 1); PG8_SCHED; PG8_LDA(At, 0, 0); PG8_STAGE(PG8_SA(1, 1), a1 + hstep, voffA);
            PG8_WAIT_V(8); PG8_WAIT_L(0); PG8_BAR; PG8_MMA(0, 0, At, B0); PG8_MMA(0, 1, At, B1); PG8_BAR; PG8_SCHED;
            PG8_LDA(At, 0, 1); PG8_STAGE(PG8_SB(0, 0), b2, voffB); PG8_STAGE(PG8_SB(0, 1), b2 + hstep, voffB); PG8_STAGE(PG8_SA(0, 0), a2, voffA);
            PG8_WAIT_V(8); PG8_WAIT_L(0); PG8_BAR; PG8_MMA(1, 0, At, B0); PG8_MMA(1, 1, At, B1); PG8_BAR; PG8_SCHED;
            PG8_LDB(B0, 1, 0); PG8_LDB(B1, 1, 1); PG8_SCHED; PG8_LDA(At, 1, 0); PG8_STAGE(PG8_SA(0, 1), a2 + hstep, voffA);
            PG8_WAIT_V(8); PG8_WAIT_L(0); PG8_BAR; PG8_MMA(0, 0, At, B0); PG8_MMA(0, 1, At, B1); PG8_BAR; PG8_SCHED;
            PG8_LDA(At, 1, 1); PG8_STAGE(PG8_SB(1, 0), b3, voffB); PG8_STAGE(PG8_SB(1, 1), b3 + hstep, voffB); PG8_STAGE(PG8_SA(1, 0), a3, voffA);
            PG8_WAIT_V(8); PG8_WAIT_L(0); PG8_BAR; PG8_MMA(1, 0, At, B0); PG8_MMA(1, 1, At, B1); PG8_BAR; PG8_SCHED;
            } else {
            PG8_LDB(B0, 0, 0); PG8_SCHED; PG8_LDA(At, 0, 0); PG8_STAGE(PG8_SA(1, 1), a1 + hstep, voffA);
            PG8_WAIT_L(8); PG8_BAR; PG8_WAIT_L(0); PG8_MMA(0, 0, At, B0); PG8_BAR; PG8_SCHED;
            PG8_LDB(B1, 0, 1); PG8_STAGE(PG8_SB(0, 0), b2, voffB);
            PG8_BAR; PG8_WAIT_L(0); PG8_MMA(0, 1, At, B1); PG8_BAR;
            PG8_LDA(At, 0, 1); PG8_STAGE(PG8_SA(0, 0), a2, voffA);
            PG8_BAR; PG8_WAIT_L(0); PG8_MMA(1, 0, At, B0); PG8_BAR; PG8_SCHED;
            PG8_STAGE(PG8_SB(0, 1), b2 + hstep, voffB);
            PG8_WAIT_V(6); PG8_BAR; PG8_MMA(1, 1, At, B1); PG8_BAR;
            PG8_LDB(B0, 1, 0); PG8_SCHED; PG8_LDA(At, 1, 0); PG8_STAGE(PG8_SA(0, 1), a2 + hstep, voffA);
            PG8_WAIT_L(8); PG8_BAR; PG8_WAIT_L(0); PG8_MMA(0, 0, At, B0); PG8_BAR; PG8_SCHED;
            PG8_LDB(B1, 1, 1); PG8_STAGE(PG8_SB(1, 0), b3, voffB);
            PG8_BAR; PG8_WAIT_L(0); PG8_MMA(0, 1, At, B1); PG8_BAR;
            PG8_LDA(At, 1, 1); PG8_STAGE(PG8_SA(1, 0), a3, voffA);
            PG8_BAR; PG8_WAIT_L(0); PG8_MMA(1, 0, At, B0); PG8_BAR; PG8_SCHED;
            PG8_STAGE(PG8_SB(1, 1), b3 + hstep, voffB);
            PG8_WAIT_V(6); PG8_BAR; PG8_MMA(1, 1, At, B1); PG8_BAR;
            }
        }
        if constexpr (ALIGN_EPI) { if (wr == 0) PG8_BAR; }
        if constexpr (!Epi::AFTER_DRAIN) { E(acc, cur, wr, wc, fr, fq); S.done(cur); }
        if (!has_next) break;
#pragma unroll
        for (int a = 0; a < 2; ++a)
#pragma unroll
            for (int b = 0; b < 2; ++b)
#pragma unroll
                for (int m = 0; m < 4; ++m)
#pragma unroll
                    for (int n = 0; n < 2; ++n) acc[a][b][m][n] = (f32x4){0.f, 0.f, 0.f, 0.f};
        cur = nxt; cA = nA; cB = nB; ++ui;
        if constexpr (ALIGN_EPI) { if (wr == 1) PG8_BAR; }
    }
    PG8_WAIT_V(0);
    if constexpr (!ALIGN_EPI) { if (wr == 0) PG8_BAR; }
    PG8_BAR;
    if constexpr (Epi::AFTER_DRAIN) { E.fused(acc, cur, wr, wc, fr, fq, lds, wid, lane); S.done(cur); }
#undef PG8_SA
#undef PG8_SB
#undef PG8_STAGE
#undef PG8_LDA
#undef PG8_LDB
#undef PG8_MMA
#undef PG8_WAIT_V
#undef PG8_WAIT_L
#undef PG8_BAR
#undef PG8_SCHED
}
}
constexpr int NWAVES = 8;
constexpr int D = 4096, BATCH = 4, SEQ = 4096, M = BATCH * SEQ, DEPTH = 2;
constexpr int S5W = 1024, SGW = 1024, HGW = 2048, PROJ = 11264, DFF = 11008, PLE = 256;
constexpr int C_XA = 0, C_U = 1024, C_V = 2048, C_Q = 3072, C_F = 5120, C_I = 7168, C_G = 9216;
constexpr float LN_EPS = 1e-5f, RMS_EPS = 1e-6f;
constexpr float ALPHA = 1.4142135623730951f;
enum { I_X = 0, I_P, I_WIN, I_LAMRE, I_LAMIM, I_LOGSTEP, I_BRE, I_BIM, I_CRE, I_CIM, I_S5D, I_WGLU, I_SGLNW, I_SGLNB, I_SGW, I_SGB, I_HGLB, I_HGNW, I_NAW, I_NBW, I_WOUT, I_LN1W, I_LN1B,
       I_WFI, I_WFO, I_LN2W, I_LN2B, I_WPI, I_WPG, I_LN3W, I_LN3B, N_IN };
constexpr size_t MiB = 1u << 20;
constexpr size_t WS_CTL = 0, CTL_ZERO_BYTES = 1 * MiB;
constexpr size_t WS_W = 2 * MiB, WL_STRIDE = 416 * MiB;
constexpr size_t WO_IN = 0, WO_GLU = 88 * MiB, WO_OUT = 90 * MiB, WO_FI = 122 * MiB, WO_FO = 294 * MiB, WO_PI = 380 * MiB, WO_PG = 382 * MiB;
constexpr size_t WS_PB = WS_W + 2 * WL_STRIDE;
constexpr size_t WS_HF = WS_PB + 16 * MiB;
constexpr size_t WS_HB = WS_HF + 256 * MiB;
constexpr size_t WS_T = WS_HB + 128 * MiB;
constexpr size_t WS_PROJ = WS_T + 256 * MiB;
constexpr size_t WS_CAT = WS_PROJ + 352 * MiB;
constexpr size_t WS_Z = WS_CAT + 128 * MiB;
constexpr size_t WS_ZA = WS_Z + 32 * MiB;
constexpr size_t WS_UZ = WS_ZA + 64 * MiB;
constexpr size_t WS_O = WS_UZ + 64 * MiB;
constexpr size_t WS_STAT = WS_O + 128 * MiB;
constexpr size_t WS_QS = WS_STAT + 1 * MiB;
constexpr size_t WS_END = WS_QS + 128 * MiB;
constexpr int CW_BAR = 4096;
constexpr int RING_OFF = 0, RING_BYTES = 131072;
constexpr int LDSCTL_OFF = RING_BYTES, MISC_OFF = LDSCTL_OFF + 320;
constexpr int LDS_BYTES = 147456;
#define GAS __attribute__((address_space(1)))
#define LAS __attribute__((address_space(3)))
typedef unsigned short bf16;
typedef unsigned v4u __attribute__((ext_vector_type(4)));
typedef float f32x4 __attribute__((ext_vector_type(4)));
typedef short bf16x8 __attribute__((ext_vector_type(8)));
typedef GAS unsigned gu32;
typedef GAS unsigned long long gu64;
#define RLX_AGENT __ATOMIC_RELAXED, __HIP_MEMORY_SCOPE_AGENT
#define LDS_WAIT() asm volatile("s_waitcnt lgkmcnt(0)" ::: "memory")
#define VM_WAIT() asm volatile("s_waitcnt vmcnt(0)" ::: "memory")
__device__ __forceinline__ unsigned long long rt() { return __builtin_amdgcn_s_memrealtime(); }
__device__ __forceinline__ unsigned f2bf(float f) { unsigned u = __builtin_bit_cast(unsigned, f); return (u + 0x7fffu + ((u >> 16) & 1u)) >> 16; }
__device__ __forceinline__ unsigned pk2(float lo, float hi) { return f2bf(lo) | (f2bf(hi) << 16); }

#define XB_TMO      128
#define XB_XCNT(j)  (256  + 64 * (j))
#define XB_XSUB(j)  (1280 + 64 * (j))
#define XB_XGEN(j)  (2304 + 64 * (j))
#define XB_TOP      3328
#define XB_TOPGEN   3392
#define XCD_BAR_WORDS 3456
#define XB_SPIN_CAP (1u << 18)

__device__ __forceinline__ unsigned xb_ld(unsigned* p)              { return __hip_atomic_load(p, __ATOMIC_RELAXED, __HIP_MEMORY_SCOPE_AGENT); }
__device__ __forceinline__ unsigned xb_add(unsigned* p, unsigned v) { return __hip_atomic_fetch_add(p, v, __ATOMIC_RELAXED, __HIP_MEMORY_SCOPE_AGENT); }
__device__ __forceinline__ unsigned xb_xcc_id() { return (unsigned)__builtin_amdgcn_s_getreg((3 << 11) | 20) & 0xFu; }
#define XB_SPIN(cond, bar) do { unsigned _sp = 0; while (cond) { __builtin_amdgcn_s_sleep(1); \
    if ((++_sp & 255u) == 0u) { if (xb_ld(&(bar)[XB_TMO])) break; if (_sp > XB_SPIN_CAP) { atomicAdd(&(bar)[XB_TMO], 1u); break; } } } } while (0)

struct XcdBarrier {
    unsigned* bar; unsigned x;
    volatile LAS unsigned* st;
};

__device__ __forceinline__ XcdBarrier xcd_barrier_post(unsigned* bar, volatile LAS unsigned* st) {
    XcdBarrier b; b.bar = bar; b.x = xb_xcc_id(); b.st = st;
    if (threadIdx.x == 0) (void)xb_add(&bar[XB_XCNT(b.x)], 1u);
    return b;
}
__device__ __forceinline__ void xcd_barrier_complete(unsigned* bar, unsigned x, unsigned& nloc, unsigned& nx) {
    const unsigned G = gridDim.x * gridDim.y * gridDim.z;
    unsigned sum, cnt, mine, sp = 0u;
    for (;;) {
        sum = 0u; cnt = 0u; mine = 0u;
#pragma unroll
        for (unsigned j = 0; j < 16; ++j) { const unsigned c = xb_ld(&bar[XB_XCNT(j)]); sum += c; cnt += (c > 0u) ? 1u : 0u; mine = (j == x) ? c : mine; }
        if (sum == G) break;
        __builtin_amdgcn_s_sleep(1);
        if ((++sp & 255u) == 0u) { if (xb_ld(&bar[XB_TMO])) break; if (sp > XB_SPIN_CAP) { atomicAdd(&bar[XB_TMO], 1u); break; } }
    }
    nloc = mine > 0u ? mine : 1u; nx = cnt > 0u ? cnt : 1u;
}

__device__ __forceinline__ void xcd_barrier(const XcdBarrier& b) {
    asm volatile("s_waitcnt vmcnt(0)" ::: "memory");
    __syncthreads();
    if (threadIdx.x == 0) {
        unsigned* bar = b.bar;
        __builtin_amdgcn_s_waitcnt(0);
        unsigned nloc = b.st[0], nx = b.st[1];
        if (nloc == 0u) { xcd_barrier_complete(bar, b.x, nloc, nx); b.st[0] = nloc; b.st[1] = nx; }
        const unsigned old = xb_add(&bar[XB_XSUB(b.x)], 1u);
        const unsigned gen = old / nloc;
        if (old + 1u == (gen + 1u) * nloc) {
            __builtin_amdgcn_fence(__ATOMIC_RELEASE, "agent");
            asm volatile("s_waitcnt vmcnt(0)" ::: "memory");
            const unsigned og = xb_add(&bar[XB_TOP], 1u);
            const unsigned tg = og / nx;
            if (og + 1u == (tg + 1u) * nx) xb_add(&bar[XB_TOPGEN], 1u);
            else XB_SPIN(xb_ld(&bar[XB_TOPGEN]) == tg, bar);
            __builtin_amdgcn_fence(__ATOMIC_ACQUIRE, "agent");
            xb_add(&bar[XB_XGEN(b.x)], 1u);
            asm volatile("s_waitcnt vmcnt(0)" ::: "memory");
        } else {
            XB_SPIN(xb_ld(&bar[XB_XGEN(b.x)]) == gen, bar);
            __builtin_amdgcn_fence(__ATOMIC_ACQUIRE, "agent");
            asm volatile("s_waitcnt vmcnt(0)" ::: "memory");
        }
    }
    __syncthreads();
}
struct Args { const float* in[N_IN]; float* out; unsigned char* ws; int ph_lo, ph_hi; };
struct Frame {
    LAS unsigned char* lds;
    int tid, lane, wave, vcu, G;
};
__device__ __forceinline__ int opaque(int v) { asm volatile("" : "+v"(v)); return v; }
__device__ __forceinline__ float wave_sum(float v) {
#pragma unroll
    for (int o = 1; o < 64; o <<= 1) v += __shfl_xor(v, o);
    return v;
}
__device__ __forceinline__ float bflo(unsigned w) { return __uint_as_float(w << 16); }
__device__ __forceinline__ float bfhi(unsigned w) { return __uint_as_float(w & 0xffff0000u); }
__device__ __forceinline__ float bf1(bf16 h) { return __uint_as_float(((unsigned)h) << 16); }
__device__ __forceinline__ float sigmoid_f(float x) { return 1.0f / (1.0f + __expf(-x)); }
__device__ __forceinline__ float silu_f(float x) { return x * sigmoid_f(x); }
__device__ __forceinline__ float gelu_f(float x) { const float a = 0.7978845608028654f * (x + 0.044715f * x * x * x); return x * sigmoid_f(2.0f * a); }

__device__ __forceinline__ void p0_transpose_item(const float* W, int K, int N, bf16* WT, int swz, LAS float* scr, int item, int lane) {
    const int nblk = N / 32, kb = item / nblk, nb = item % nblk, k0 = 64 * kb, n0 = 32 * nb;
#pragma unroll 8
    for (int i = 0; i < 32; ++i) { const int kk = 2 * i + (lane >> 5); scr[kk * 33 + (lane & 31)] = W[(size_t)(k0 + kk) * N + n0 + (lane & 31)]; }
    LDS_WAIT(); asm volatile("" ::: "memory");
    const int c = lane & 7;
    int r0 = n0;
    if (swz) { r0 = (n0 < DFF) ? (n0 / 128) * 256 + (n0 % 128) : ((n0 - DFF) / 128) * 256 + 128 + ((n0 - DFF) % 128); }
#pragma unroll
    for (int j = 0; j < 4; ++j) { const int n = (lane >> 3) + 8 * j; const LAS float* s = scr + (8 * c) * 33 + n;
        v4u o; o.x = pk2(s[0 * 33], s[1 * 33]); o.y = pk2(s[2 * 33], s[3 * 33]); o.z = pk2(s[4 * 33], s[5 * 33]); o.w = pk2(s[6 * 33], s[7 * 33]);
        *(GAS v4u*)(WT + (size_t)(r0 + n) * K + k0 + 8 * c) = o; }
    LDS_WAIT(); asm volatile("" ::: "memory");
}
__device__ __forceinline__ void p0_prologue(const Args& A, Frame& F) {
    LAS float* scr = (LAS float*)(F.lds + RING_OFF + F.wave * 16384);
    const int gw = F.vcu * NWAVES + F.wave, NGW = F.G * NWAVES; const int lane = opaque(F.lane);
    constexpr int IT_IN = (D / 64) * (PROJ / 32), IT_GLU = (S5W / 64) * (S5W / 32), IT_OUT = (D / 64) * (D / 32), IT_FI = (D / 64) * (2 * DFF / 32), IT_FO = (DFF / 64) * (D / 32), IT_PI = (PLE / 64) * (D / 32), IT_PG = IT_OUT;
    constexpr int IT_L = IT_IN + IT_GLU + IT_OUT + IT_FI + IT_FO + IT_PI + IT_PG;
    for (int it = gw; it < DEPTH * IT_L; it += NGW) {
        const int l = it / IT_L; int r = it % IT_L;
        bf16* wl = (bf16*)(A.ws + WS_W + (size_t)l * WL_STRIDE);
        if (r < IT_IN) { p0_transpose_item(A.in[I_WIN] + (size_t)l * D * PROJ, D, PROJ, (bf16*)((unsigned char*)wl + WO_IN), 0, scr, r, lane); continue; } r -= IT_IN;
        if (r < IT_GLU) { p0_transpose_item(A.in[I_WGLU] + (size_t)l * S5W * S5W, S5W, S5W, (bf16*)((unsigned char*)wl + WO_GLU), 0, scr, r, lane); continue; } r -= IT_GLU;
        if (r < IT_OUT) { p0_transpose_item(A.in[I_WOUT] + (size_t)l * D * D, D, D, (bf16*)((unsigned char*)wl + WO_OUT), 0, scr, r, lane); continue; } r -= IT_OUT;
        if (r < IT_FI) { p0_transpose_item(A.in[I_WFI] + (size_t)l * D * 2 * DFF, D, 2 * DFF, (bf16*)((unsigned char*)wl + WO_FI), 1, scr, r, lane); continue; } r -= IT_FI;
        if (r < IT_FO) { p0_transpose_item(A.in[I_WFO] + (size_t)l * DFF * D, DFF, D, (bf16*)((unsigned char*)wl + WO_FO), 0, scr, r, lane); continue; } r -= IT_FO;
        if (r < IT_PI) { p0_transpose_item(A.in[I_WPI] + (size_t)l * PLE * D, PLE, D, (bf16*)((unsigned char*)wl + WO_PI), 0, scr, r, lane); continue; } r -= IT_PI;
        p0_transpose_item(A.in[I_WPG] + (size_t)l * D * D, D, D, (bf16*)((unsigned char*)wl + WO_PG), 0, scr, r, lane);
    }
    { const float* x = A.in[I_X]; bf16* hb = (bf16*)(A.ws + WS_HB); const size_t n8 = (size_t)M * D / 8;
      for (size_t i = (size_t)gw * 64 + lane; i < n8; i += (size_t)NGW * 64) { const f32x4 a = *(const f32x4*)(x + i * 8), b = *(const f32x4*)(x + i * 8 + 4);
          v4u o; o.x = pk2(a[0], a[1]); o.y = pk2(a[2], a[3]); o.z = pk2(b[0], b[1]); o.w = pk2(b[2], b[3]); *(v4u*)(hb + i * 8) = o; } }
    { const float* p = A.in[I_P]; bf16* pb = (bf16*)(A.ws + WS_PB); const size_t n8 = (size_t)DEPTH * M * PLE / 8;
      for (size_t i = (size_t)gw * 64 + lane; i < n8; i += (size_t)NGW * 64) { const f32x4 a = *(const f32x4*)(p + i * 8), b = *(const f32x4*)(p + i * 8 + 4);
          v4u o; o.x = pk2(a[0], a[1]); o.y = pk2(a[2], a[3]); o.z = pk2(b[0], b[1]); o.w = pk2(b[2], b[3]); *(v4u*)(pb + i * 8) = o; } }
}

__device__ __forceinline__ void ln_phase(Frame& F, const float* T, const float* w, const float* b, float* outF, bf16* outB) {
    const int gw = F.vcu * NWAVES + F.wave, NGW = F.G * NWAVES; const int lane = opaque(F.lane);
    for (int m = gw; m < M; m += NGW) {
        const f32x4* xr = (const f32x4*)(T + (size_t)m * D) + lane;
        f32x4 v[16]; float s = 0.f;
#pragma unroll
        for (int j = 0; j < 16; ++j) { v[j] = xr[64 * j]; s += (v[j][0] + v[j][1]) + (v[j][2] + v[j][3]); }
        const float mean = wave_sum(s) * (1.f / D); float s2 = 0.f;
#pragma unroll
        for (int j = 0; j < 16; ++j) { v[j] = v[j] - mean; s2 += (v[j][0] * v[j][0] + v[j][1] * v[j][1]) + (v[j][2] * v[j][2] + v[j][3] * v[j][3]); }
        const float rstd = 1.f / sqrtf(wave_sum(s2) * (1.f / D) + LN_EPS);
#pragma unroll
        for (int j = 0; j < 16; ++j) { const f32x4 wv = ((const f32x4*)w)[64 * j + lane], bv = ((const f32x4*)b)[64 * j + lane];
            const f32x4 y = v[j] * rstd * wv + bv;
            ((f32x4*)(outF + (size_t)m * D))[64 * j + lane] = y;
            if (outB) { unsigned long long o = (unsigned long long)pk2(y[0], y[1]) | ((unsigned long long)pk2(y[2], y[3]) << 32); ((unsigned long long*)(outB + (size_t)m * D))[64 * j + lane] = o; } }
    }
}

__device__ __forceinline__ void norm_phase(const Args& A, Frame& F, int l) {
    const int gw = F.vcu * NWAVES + F.wave, NGW = F.G * NWAVES; const int lane = opaque(F.lane);
    const float* za = (const float*)(A.ws + WS_ZA); const float* uz = (const float*)(A.ws + WS_UZ); const float* o = (const float*)(A.ws + WS_O);
    const bf16* proj = (const bf16*)(A.ws + WS_PROJ); bf16* cat = (bf16*)(A.ws + WS_CAT);
    const float* naw = A.in[I_NAW] + l * S5W; const float* nbw = A.in[I_NBW] + l * SGW; const float* hnw = A.in[I_HGNW] + l * 128;
    for (int m = gw; m < M; m += NGW) {
        {   f32x4 v[4]; float ss = 0.f;
#pragma unroll
            for (int j = 0; j < 4; ++j) { v[j] = ((const f32x4*)(za + (size_t)m * S5W))[64 * j + lane]; ss += (v[j][0] * v[j][0] + v[j][1] * v[j][1]) + (v[j][2] * v[j][2] + v[j][3] * v[j][3]); }
            const float r = 1.f / sqrtf(wave_sum(ss) * (1.f / S5W) + RMS_EPS);
#pragma unroll
            for (int j = 0; j < 4; ++j) { const f32x4 wv = ((const f32x4*)naw)[64 * j + lane]; const f32x4 y = v[j] * r * wv;
                ((unsigned long long*)(cat + (size_t)m * D))[64 * j + lane] = (unsigned long long)pk2(y[0], y[1]) | ((unsigned long long)pk2(y[2], y[3]) << 32); } }
        {   f32x4 v[4]; float ss = 0.f;
#pragma unroll
            for (int j = 0; j < 4; ++j) { v[j] = ((const f32x4*)(uz + (size_t)m * SGW))[64 * j + lane]; ss += (v[j][0] * v[j][0] + v[j][1] * v[j][1]) + (v[j][2] * v[j][2] + v[j][3] * v[j][3]); }
            const float r = 1.f / sqrtf(wave_sum(ss) * (1.f / SGW) + RMS_EPS);
#pragma unroll
            for (int j = 0; j < 4; ++j) { const f32x4 wv = ((const f32x4*)nbw)[64 * j + lane]; const f32x4 y = v[j] * r * wv;
                ((unsigned long long*)(cat + (size_t)m * D + S5W))[64 * j + lane] = (unsigned long long)pk2(y[0], y[1]) | ((unsigned long long)pk2(y[2], y[3]) << 32); } }
#pragma unroll
        for (int j = 0; j < 8; ++j) {
            const f32x4 v = ((const f32x4*)(o + (size_t)m * HGW))[64 * j + lane];
            float ss = (v[0] * v[0] + v[1] * v[1]) + (v[2] * v[2] + v[3] * v[3]);
#pragma unroll
            for (int sh = 1; sh < 32; sh <<= 1) ss += __shfl_xor(ss, sh);
            const float r = 1.f / sqrtf(ss * (1.f / 128.f) + RMS_EPS);
            const f32x4 wv = ((const f32x4*)hnw)[lane & 31];
            const unsigned long long gw2 = ((const unsigned long long*)(proj + (size_t)m * PROJ + C_G))[64 * j + lane];
            const unsigned glo = (unsigned)gw2, ghi = (unsigned)(gw2 >> 32);
            f32x4 y; y[0] = v[0] * r * wv[0] * silu_f(bflo(glo)); y[1] = v[1] * r * wv[1] * silu_f(bfhi(glo)); y[2] = v[2] * r * wv[2] * silu_f(bflo(ghi)); y[3] = v[3] * r * wv[3] * silu_f(bfhi(ghi));
            ((unsigned long long*)(cat + (size_t)m * D + S5W + SGW))[64 * j + lane] = (unsigned long long)pk2(y[0], y[1]) | ((unsigned long long)pk2(y[2], y[3]) << 32);
        }
    }
}
__device__ __forceinline__ void s5_naive_item(const Args& A, int l, int item, int lane) {
    const int b = item >> 6, g = item & 63, n = lane;
    const float lr = fminf(A.in[I_LAMRE][(l * 64 + g) * 64 + n], -1e-4f), li = A.in[I_LAMIM][(l * 64 + g) * 64 + n];
    const float dt = expf(A.in[I_LOGSTEP][l * 64 + g]);
    const float mag = expf(lr * dt), ab_re = mag * cosf(li * dt), ab_im = mag * sinf(li * dt);
    const float den = lr * lr + li * li, nr = ab_re - 1.0f;
    const float g_re = (nr * lr + ab_im * li) / den, g_im = (ab_im * lr - nr * li) / den;
    float bbr[16], bbi[16], cre[16], cim[16];
    const float* brp = A.in[I_BRE] + ((size_t)(l * 64 + g) * 64 + n) * 16; const float* bip = A.in[I_BIM] + ((size_t)(l * 64 + g) * 64 + n) * 16;
#pragma unroll
    for (int c = 0; c < 16; ++c) { const float br = brp[c], bi = bip[c]; bbr[c] = g_re * br - g_im * bi; bbi[c] = g_re * bi + g_im * br;
        cre[c] = A.in[I_CRE][((size_t)(l * 64 + g) * 16 + c) * 64 + n]; cim[c] = A.in[I_CIM][((size_t)(l * 64 + g) * 16 + c) * 64 + n]; }
    const int cl = lane >> 2;
    const float dc = A.in[I_S5D][l * S5W + g * 16 + cl];
    const bf16* proj = (const bf16*)(A.ws + WS_PROJ); bf16* z = (bf16*)(A.ws + WS_Z);
    float sre = 0.f, sim = 0.f;
    const bool h5 = (lane & 32) != 0, h4 = (lane & 16) != 0, h3 = (lane & 8) != 0, h2 = (lane & 4) != 0;
#pragma unroll 2
    for (int t = 0; t < SEQ; ++t) {
        const size_t row = (size_t)b * SEQ + t;
        const v4u w0 = *(const v4u*)(proj + row * PROJ + C_XA + g * 16), w1 = *(const v4u*)(proj + row * PROJ + C_XA + g * 16 + 8);
        const float uc = bf1(proj[row * PROJ + C_XA + g * 16 + cl]);
        float u[16];
        u[0] = bflo(w0.x); u[1] = bfhi(w0.x); u[2] = bflo(w0.y); u[3] = bfhi(w0.y); u[4] = bflo(w0.z); u[5] = bfhi(w0.z); u[6] = bflo(w0.w); u[7] = bfhi(w0.w);
        u[8] = bflo(w1.x); u[9] = bfhi(w1.x); u[10] = bflo(w1.y); u[11] = bfhi(w1.y); u[12] = bflo(w1.z); u[13] = bfhi(w1.z); u[14] = bflo(w1.w); u[15] = bfhi(w1.w);
        float bur = 0.f, bui = 0.f;
#pragma unroll
        for (int c = 0; c < 16; ++c) { bur += bbr[c] * u[c]; bui += bbi[c] * u[c]; }
        const float nre = ab_re * sre - ab_im * sim + bur, nim = ab_re * sim + ab_im * sre + bui;
        sre = nre; sim = nim;
        float p[16];
#pragma unroll
        for (int c = 0; c < 16; ++c) p[c] = cre[c] * sre - cim[c] * sim;
        float q[8], r4[4], s2[2];
#pragma unroll
        for (int j = 0; j < 8; ++j) { const float keep = h5 ? p[j + 8] : p[j], send = h5 ? p[j] : p[j + 8]; q[j] = keep + __shfl_xor(send, 32); }
#pragma unroll
        for (int j = 0; j < 4; ++j) { const float keep = h4 ? q[j + 4] : q[j], send = h4 ? q[j] : q[j + 4]; r4[j] = keep + __shfl_xor(send, 16); }
#pragma unroll
        for (int j = 0; j < 2; ++j) { const float keep = h3 ? r4[j + 2] : r4[j], send = h3 ? r4[j] : r4[j + 2]; s2[j] = keep + __shfl_xor(send, 8); }
        float y; { const float keep = h2 ? s2[1] : s2[0], send = h2 ? s2[0] : s2[1]; y = keep + __shfl_xor(send, 4); }
        y += __shfl_xor(y, 1); y += __shfl_xor(y, 2);
        y += dc * uc;
        if ((lane & 3) == 0) z[row * S5W + g * 16 + cl] = (bf16)f2bf(gelu_f(y));
    }
}
__device__ __forceinline__ void sgu_stats_row(const Args& A, int m, int lane) {
    const bf16* proj = (const bf16*)(A.ws + WS_PROJ); float* st = (float*)(A.ws + WS_STAT);
    float v[16];
#pragma unroll
    for (int j = 0; j < 2; ++j) { const v4u w = *(const v4u*)(proj + (size_t)m * PROJ + C_V + 512 * j + 8 * lane);
        v[8 * j + 0] = gelu_f(bflo(w.x)); v[8 * j + 1] = gelu_f(bfhi(w.x)); v[8 * j + 2] = gelu_f(bflo(w.y)); v[8 * j + 3] = gelu_f(bfhi(w.y));
        v[8 * j + 4] = gelu_f(bflo(w.z)); v[8 * j + 5] = gelu_f(bfhi(w.z)); v[8 * j + 6] = gelu_f(bflo(w.w)); v[8 * j + 7] = gelu_f(bfhi(w.w)); }
    float s = 0.f;
#pragma unroll
    for (int j = 0; j < 16; ++j) s += v[j];
    const float mean = wave_sum(s) * (1.f / SGW); float s2 = 0.f;
#pragma unroll
    for (int j = 0; j < 16; ++j) { const float d = v[j] - mean; s2 += d * d; }
    const float rstd = 1.f / sqrtf(wave_sum(s2) * (1.f / SGW) + LN_EPS);
    if (lane == 0) { st[2 * m] = mean; st[2 * m + 1] = rstd; }
}
__device__ __forceinline__ void hg_gates_row(const Args& A, int l, int m, int lane) {
    const bf16* proj = (const bf16*)(A.ws + WS_PROJ);
    float* fd = (float*)(A.ws + WS_T); float* kk = fd + (size_t)M * HGW; float* qs = (float*)(A.ws + WS_QS);
#pragma unroll
    for (int j = 0; j < 8; ++j) {
        const int col = 256 * j + 4 * lane;
        const unsigned long long fw = *(const unsigned long long*)(proj + (size_t)m * PROJ + C_F + col), qw = *(const unsigned long long*)(proj + (size_t)m * PROJ + C_Q + col);
        f32x4 lb = (f32x4){0.f, 0.f, 0.f, 0.f};
        if (l == 1) { const f32x4 l0 = *(const f32x4*)(A.in[I_HGLB] + col), l1 = *(const f32x4*)(A.in[I_HGLB] + HGW + col);
#pragma unroll
            for (int e = 0; e < 4; ++e) lb[e] = sigmoid_f(l1[e] - l0[e]); }
        const float fr[4] = {bflo((unsigned)fw), bfhi((unsigned)fw), bflo((unsigned)(fw >> 32)), bfhi((unsigned)(fw >> 32))};
        const float qr[4] = {bflo((unsigned)qw), bfhi((unsigned)qw), bflo((unsigned)(qw >> 32)), bfhi((unsigned)(qw >> 32))};
        f32x4 fo, ko, qo;
#pragma unroll
        for (int e = 0; e < 4; ++e) { fo[e] = lb[e] + (1.f - lb[e]) * sigmoid_f(fr[e]); ko[e] = (1.f - lb[e]) * sigmoid_f(-fr[e]); qo[e] = silu_f(qr[e]); }
        *(f32x4*)(fd + (size_t)m * HGW + col) = fo; *(f32x4*)(kk + (size_t)m * HGW + col) = ko; *(f32x4*)(qs + (size_t)m * HGW + col) = qo;
    }
}
__device__ __forceinline__ void sgu_naive_item(const Args& A, Frame& F, int l, int item) {
    const int ch = item >> 3, h = item & 7, cs = ch * 128; const int tid = opaque(F.tid);
    const bf16* proj = (const bf16*)(A.ws + WS_PROJ); const float* st = (const float*)(A.ws + WS_STAT); float* uz = (float*)(A.ws + WS_UZ);
    LAS float* vn = (LAS float*)(F.lds + RING_OFF); LAS float* Wl = (LAS float*)(F.lds + RING_OFF + 65536);
    const int d = tid & 127, tg = tid >> 7;
    const float lw = A.in[I_SGLNW][l * SGW + h * 128 + d], lbias = A.in[I_SGLNB][l * SGW + h * 128 + d];
    for (int i = 0; i < 32; ++i) { const int s = tg + 4 * i; const size_t row = (size_t)cs + s;
        const float x = gelu_f(bf1(proj[row * PROJ + C_V + h * 128 + d]));
        vn[s * 128 + d] = (x - st[2 * row]) * st[2 * row + 1] * lw + lbias; }
    const float* Wg = A.in[I_SGW] + ((size_t)(l * 8 + h) * 128) * 128;
    for (int i = tid; i < 128 * 128 / 4; i += 512) ((LAS f32x4*)Wl)[i] = ((const f32x4*)Wg)[i];
    __syncthreads();
    for (int i = 0; i < 32; ++i) { const int t = tg + 4 * i; float acc = 0.f;
        for (int s = 0; s <= t; ++s) acc += Wl[t * 128 + s] * vn[s * 128 + d];
        acc += A.in[I_SGB][(l * 8 + h) * 128 + t];
        const size_t row = (size_t)cs + t;
        uz[row * SGW + h * 128 + d] = gelu_f(bf1(proj[row * PROJ + C_U + h * 128 + d])) * acc; }
    __syncthreads();
}
__device__ __forceinline__ void hg_naive_item(const Args& A, Frame& F, int item) {
    const int b = item >> 6, h = (item >> 2) & 15, vq = item & 3;
    const int lane = opaque(F.lane); const int jl = lane >> 4, kg = lane & 15, j = 4 * F.wave + jl;
    const bf16* proj = (const bf16*)(A.ws + WS_PROJ);
    const float* fd = (const float*)(A.ws + WS_T); const float* kk = fd + (size_t)M * HGW; const float* qs = (const float*)(A.ws + WS_QS); float* o = (float*)(A.ws + WS_O);
    float s[8];
#pragma unroll
    for (int e = 0; e < 8; ++e) s[e] = 0.f;
#pragma unroll 4
    for (int t = 0; t < SEQ; ++t) {
        const size_t row = (size_t)b * SEQ + t; const size_t base = row * HGW + h * 128 + kg * 8;
        const f32x4 f0 = *(const f32x4*)(fd + base), f1 = *(const f32x4*)(fd + base + 4), k0 = *(const f32x4*)(kk + base), k1 = *(const f32x4*)(kk + base + 4), q0 = *(const f32x4*)(qs + base), q1 = *(const f32x4*)(qs + base + 4);
        const float vj = bf1(proj[row * PROJ + C_I + h * 128 + vq * 32 + j]);
        float acc = 0.f;
#pragma unroll
        for (int e = 0; e < 4; ++e) { s[e] = f0[e] * s[e] + k0[e] * vj; acc += q0[e] * s[e]; s[4 + e] = f1[e] * s[4 + e] + k1[e] * vj; acc += q1[e] * s[4 + e]; }
        acc += __shfl_xor(acc, 1); acc += __shfl_xor(acc, 2); acc += __shfl_xor(acc, 4); acc += __shfl_xor(acc, 8);
        if (kg == 0) o[row * HGW + h * 128 + vq * 32 + j] = acc;
    }
}
constexpr int PH_PER_LAYER = 13, N_PHASES = 1 + DEPTH * PH_PER_LAYER;
#ifndef MK_ONE_LAUNCH
#define MK_ONE_LAUNCH 0
#endif
__global__ void __launch_bounds__(NWAVES * 64, 2) mega_fwd(Args args) {
    extern __shared__ __attribute__((aligned(16))) unsigned char lds[];
    Frame F;
    F.lds = (LAS unsigned char*)lds;
    F.tid = threadIdx.x; F.lane = F.tid & 63; F.wave = __builtin_amdgcn_readfirstlane(F.tid >> 6);
    F.G = gridDim.x; { const int bx = blockIdx.x; F.vcu = (F.G % 8 == 0) ? (bx % 8) * (F.G / 8) + bx / 8 : bx; }
    unsigned char* ws = args.ws;
    unsigned* ctl = (unsigned*)(ws + WS_CTL);
    for (int u = F.tid; u < (LDS_BYTES - LDSCTL_OFF) / 4; u += NWAVES * 64) ((LAS unsigned*)(F.lds + LDSCTL_OFF))[u] = 0u;
    __syncthreads();
#if MK_ONE_LAUNCH
    XcdBarrier bar = xcd_barrier_post(ctl + CW_BAR, (volatile LAS unsigned*)(F.lds + MISC_OFF) + 8);
#define SEAM(k) do { if (IN(k) && IN((k) + 1)) xcd_barrier(bar); } while (0)
#else
#define SEAM(k) do { } while (0)
#endif
    const int lo = args.ph_lo, hi = args.ph_hi;
#define IN(k) (lo <= (k) && (k) < hi)
    const int gw = F.vcu * NWAVES + F.wave, NGW = F.G * NWAVES;

    if (IN(0)) { p0_prologue(args, F); }
    SEAM(0);
#pragma unroll 1
    for (int l = 0; l < DEPTH; ++l) {
        const int pb = 1 + l * PH_PER_LAYER;
        const unsigned char* wl = ws + WS_W + (size_t)l * WL_STRIDE;
        const float* hres = (l == 0) ? args.in[I_X] : (const float*)(ws + WS_HF);
        float* hf = (float*)(ws + WS_HF); bf16* hb = (bf16*)(ws + WS_HB); float* T = (float*)(ws + WS_T);
        if (IN(pb + 0)) { pg8::Gemm g{hb, (const bf16*)(wl + WO_IN), M, PROJ, D}; pg8::StaticOrder S; S.init(M, PROJ, F.G, (int)blockIdx.x);
            pg8::EpiBf16Plain E{(bf16*)(ws + WS_PROJ), PROJ}; pg8::gemm_phase<pg8::EpiBf16Plain, pg8::StaticOrder, true, true>(F.lds + RING_OFF, g, S, E); }
        SEAM(pb + 0);
        if (IN(pb + 1)) {
            const int lane = opaque(F.lane);
            if (F.wave == 0) { for (int it = F.vcu; it < BATCH * 64; it += F.G) s5_naive_item(args, l, it, lane); }
            else { const int gw7 = F.vcu * 7 + (F.wave - 1), NGW7 = F.G * 7; for (int m = gw7; m < M; m += NGW7) { sgu_stats_row(args, m, lane); hg_gates_row(args, l, m, lane); } }
        }
        SEAM(pb + 1);
        if (IN(pb + 2)) {
            for (int it = F.vcu; it < BATCH * 16 * 4; it += F.G) hg_naive_item(args, F, it);
            for (int it = F.vcu; it < (M / 128) * 8; it += F.G) sgu_naive_item(args, F, l, it);
        }
        SEAM(pb + 2);
        if (IN(pb + 3)) { pg8::Gemm g{(const bf16*)(ws + WS_Z), (const bf16*)(wl + WO_GLU), M, S5W, S5W}; pg8::StaticOrder S; S.init(M, S5W, F.G, (int)blockIdx.x);
            pg8::EpiGlu E{(const bf16*)(ws + WS_Z), (float*)(ws + WS_ZA), S5W}; pg8::gemm_phase<pg8::EpiGlu, pg8::StaticOrder, true, true>(F.lds + RING_OFF, g, S, E); }
        SEAM(pb + 3);
        if (IN(pb + 4)) norm_phase(args, F, l);
        SEAM(pb + 4);
        if (IN(pb + 5)) { pg8::Gemm g{(const bf16*)(ws + WS_CAT), (const bf16*)(wl + WO_OUT), M, D, D}; pg8::StaticOrder S; S.init(M, D, F.G, (int)blockIdx.x);
            pg8::EpiResF32 E{hres, T, D, ALPHA}; pg8::gemm_phase<pg8::EpiResF32, pg8::StaticOrder, true, true>(F.lds + RING_OFF, g, S, E); }
        SEAM(pb + 5);
        if (IN(pb + 6)) ln_phase(F, T, args.in[I_LN1W] + l * D, args.in[I_LN1B] + l * D, hf, hb);
        SEAM(pb + 6);
        if (IN(pb + 7)) { pg8::Gemm g{hb, (const bf16*)(wl + WO_FI), M, 2 * DFF, D}; pg8::StaticOrder S; S.init(M, 2 * DFF, F.G, (int)blockIdx.x);
            pg8::EpiSwiGLU E{(bf16*)(ws + WS_PROJ), DFF}; pg8::gemm_phase<pg8::EpiSwiGLU, pg8::StaticOrder, true, true>(F.lds + RING_OFF, g, S, E); }
        SEAM(pb + 7);
        if (IN(pb + 8)) { pg8::Gemm g{(const bf16*)(ws + WS_PROJ), (const bf16*)(wl + WO_FO), M, D, DFF}; pg8::StaticOrder S; S.init(M, D, F.G, (int)blockIdx.x);
            pg8::EpiResF32 E{hf, T, D, ALPHA}; pg8::gemm_phase<pg8::EpiResF32, pg8::StaticOrder, true, true>(F.lds + RING_OFF, g, S, E); }
        SEAM(pb + 8);
        if (IN(pb + 9)) ln_phase(F, T, args.in[I_LN2W] + l * D, args.in[I_LN2B] + l * D, hf, hb);
        SEAM(pb + 9);
        if (IN(pb + 10)) { pg8::Gemm g{(const bf16*)(ws + WS_PB) + (size_t)l * M * PLE, (const bf16*)(wl + WO_PI), M, D, PLE}; pg8::StaticOrder S; S.init(M, D, F.G, (int)blockIdx.x);
            pg8::EpiBf16Plain E{(bf16*)(ws + WS_CAT), D}; pg8::gemm_phase<pg8::EpiBf16Plain, pg8::StaticOrder, true, true>(F.lds + RING_OFF, g, S, E); }
        SEAM(pb + 10);
        if (IN(pb + 11)) { pg8::Gemm g{hb, (const bf16*)(wl + WO_PG), M, D, D}; pg8::StaticOrder S; S.init(M, D, F.G, (int)blockIdx.x);
            pg8::EpiPle E{hf, (const bf16*)(ws + WS_CAT), T, D, ALPHA}; pg8::gemm_phase<pg8::EpiPle, pg8::StaticOrder, true, true>(F.lds + RING_OFF, g, S, E); }
        SEAM(pb + 11);
        if (IN(pb + 12)) ln_phase(F, T, args.in[I_LN3W] + l * D, args.in[I_LN3B] + l * D, (l == DEPTH - 1) ? args.out : hf, (l == DEPTH - 1) ? (bf16*)nullptr : hb);
        SEAM(pb + 12);
    }
#undef IN
#undef SEAM
    (void)gw; (void)NGW; (void)ctl;
}

extern "C" void kernel_launch(void* const* d_in, const int* in_sizes, int n_in, void* d_out, int out_size, void* d_ws, size_t ws_size, hipStream_t stream) {
    static int grid = 0;
    if (grid == 0) {
        if (n_in != N_IN || in_sizes[0] != M * D || out_size != M * D || ws_size < WS_END) { fprintf(stderr, "kernel_launch: unexpected shapes: n_in %d in0 %d out %d ws %zu (need %zu)\n", n_in, n_in > 0 ? in_sizes[0] : -1, out_size, ws_size, (size_t)WS_END); grid = -1; return; }
        int dev = 0, cus = 0, per_cu = 0;
        if (hipGetDevice(&dev) != hipSuccess || hipDeviceGetAttribute(&cus, hipDeviceAttributeMultiprocessorCount, dev) != hipSuccess) { grid = -1; return; }
        if (hipFuncSetAttribute((const void*)mega_fwd, hipFuncAttributeMaxDynamicSharedMemorySize, LDS_BYTES) != hipSuccess) { fprintf(stderr, "kernel_launch: hipFuncSetAttribute failed\n"); grid = -1; return; }
        if (hipOccupancyMaxActiveBlocksPerMultiprocessor(&per_cu, (const void*)mega_fwd, NWAVES * 64, LDS_BYTES) != hipSuccess || per_cu < 1) fprintf(stderr, "kernel_launch: occupancy query says %d\n", per_cu);
        (void)hipGetLastError();
        grid = cus;
    }
    if (grid < 0) return;
    (void)hipMemsetAsync((char*)d_ws + WS_CTL, 0, CTL_ZERO_BYTES, stream);
    Args a{};
    for (int i = 0; i < N_IN; ++i) a.in[i] = (const float*)d_in[i];
    a.out = (float*)d_out; a.ws = (unsigned char*)d_ws;
#if MK_ONE_LAUNCH
    a.ph_lo = 0; a.ph_hi = N_PHASES;
    hipLaunchKernelGGL(mega_fwd, dim3(grid), dim3(NWAVES * 64), LDS_BYTES, stream, a);
#else
    for (int p = 0; p < N_PHASES; ++p) { a.ph_lo = p; a.ph_hi = p + 1; hipLaunchKernelGGL(mega_fwd, dim3(grid), dim3(NWAVES * 64), LDS_BYTES, stream, a); }
#endif
}
```

```cpp
#include <hip/hip_runtime.h>
#include <cstdio>
#include <cstdint>
namespace pg8 {
#define PG8_LAS __attribute__((address_space(3)))
typedef unsigned short bf16_t;
typedef short bf16x8 __attribute__((ext_vector_type(8)));
typedef float f32x4 __attribute__((ext_vector_type(4)));
typedef unsigned u32x4 __attribute__((ext_vector_type(4)));
constexpr int BM = 256, BK = 64, HALF = 128, HTB = HALF * BK * 2  , STAGE_BYTES = 8 * HTB, NXCD = 8, WGM = 8;

__host__ __device__ __forceinline__ int lds_byte(int r, int c) { const int st = (r >> 4) * 2 + (c >> 5), rr = r & 15, cc = c & 31, ob = rr * 64 + cc * 2; return st * 1024 + (ob ^ (((ob >> 9) & 1) << 5)); }
__host__ __device__ __forceinline__ void stage_rc(int b, int& R, int& C) { const int st = b / 1024, sb = b % 1024, swz = sb ^ (((sb >> 9) & 1) << 5); R = (st >> 1) * 16 + swz / 64; C = (st & 1) * 32 + (swz % 64) / 2; }
__host__ __device__ __forceinline__ int perm32(int rho) { const int n = rho >> 4, i = rho & 15; return 8 * (i >> 2) + 4 * n + (i & 3); }

struct Unit { int pm, pn; };
struct Gemm { const bf16_t* A; const bf16_t* Bt; int M, N, K; };

struct StaticOrder {
    int nM, nN, nwg, G, c;
    __host__ __device__ void init(int M, int N, int G_, int c_) { nM = M / BM; nN = N / BM; nwg = nM * nN; G = G_; c = c_; }
    __host__ __device__ bool next(int i, Unit& u) const {
        const long L = (long)i * G + c; if (L >= nwg) return false;
        int wgid = (int)L; { const int q = nwg / NXCD, r = nwg % NXCD, xcd = wgid % NXCD, off = wgid / NXCD; wgid = (xcd < r ? xcd * (q + 1) : r * (q + 1) + (xcd - r) * q) + off; }
        const int nig = WGM * nN, gid = wgid / nig, fm = gid * WGM, gsz = (nM - fm) < WGM ? (nM - fm) : WGM;
        u.pm = fm + ((wgid % nig) % gsz); u.pn = (wgid % nig) / gsz; return true;
    }
    __device__ __forceinline__ void a_ready(const Unit&) const {}
    __device__ __forceinline__ void done(const Unit&) const {}
};
struct PiOrder {
    int first, count, n_units;
    __host__ __device__ bool next(int i, Unit& u) const { if (i >= count) return false; const int idx = first + i; u.pm = idx >> 4; u.pn = idx & 15; return true; }
    __device__ __forceinline__ void a_ready(const Unit&) const {}
    __device__ __forceinline__ void done(const Unit&) const {}
};
typedef float f32x2 __attribute__((ext_vector_type(2)));
typedef __bf16 bf16x2v __attribute__((ext_vector_type(2)));
__device__ __forceinline__ unsigned cvt_pk_bf16(float lo, float hi) { const f32x2 v = {lo, hi}; return __builtin_bit_cast(unsigned, __builtin_convertvector(v, bf16x2v)); }
__device__ __forceinline__ float sigm(float x) { return __builtin_amdgcn_rcpf(1.0f + __builtin_amdgcn_exp2f(-1.4426950408889634f * x)); }
__device__ __forceinline__ void row_stats(const float* st, int row, float& mean, float& rstd) {
    typedef float f32x2l __attribute__((ext_vector_type(2))); const f32x2l v = *(const PG8_LAS f32x2l*)((PG8_LAS const char*)(unsigned)(unsigned long long)st + (row & 2047) * 8); mean = v[0]; rstd = v[1]; }
__device__ __forceinline__ f32x2 bf2(unsigned w) { return (f32x2){__uint_as_float(w << 16), __uint_as_float(w & 0xffff0000u)}; }
__device__ __forceinline__ f32x2 sp2(float s) { return (f32x2){s, s}; }
__device__ __forceinline__ f32x2 lo2(const f32x4 v) { return (f32x2){v[0], v[1]}; }
__device__ __forceinline__ f32x2 hi2(const f32x4 v) { return (f32x2){v[2], v[3]}; }
__device__ __forceinline__ f32x2 fma2(f32x2 a, f32x2 b, f32x2 c) { return __builtin_elementwise_fma(a, b, c); }
__device__ __forceinline__ void stat_add(float* p, float v) { __hip_atomic_fetch_add(p, v, __ATOMIC_RELAXED, __HIP_MEMORY_SCOPE_AGENT); }
struct EpiBf16Plain {
    static constexpr bool PERM = true, AFTER_DRAIN = false;
    bf16_t* O; int ldc;
    __device__ __forceinline__ void operator()(const f32x4 (&acc)[2][2][4][2], const Unit& u, int wr, int wc, int fr, int fq) const {
        const int row0 = u.pm * BM + wr * 64 + fr, col0 = u.pn * BM + wc * 32 + 8 * fq;
#pragma unroll
        for (int ai = 0; ai < 2; ++ai)
#pragma unroll
            for (int m = 0; m < 4; ++m) { bf16_t* rowp = O + (size_t)(row0 + ai * HALF + m * 16) * ldc + col0;
#pragma unroll
                for (int bj = 0; bj < 2; ++bj) { const f32x4 v0 = acc[ai][bj][m][0], v1 = acc[ai][bj][m][1];
                    u32x4 w; w.x = cvt_pk_bf16(v0[0], v0[1]); w.y = cvt_pk_bf16(v0[2], v0[3]); w.z = cvt_pk_bf16(v1[0], v1[1]); w.w = cvt_pk_bf16(v1[2], v1[3]);
                    *(u32x4*)(rowp + bj * HALF) = w; } }
    }
};
struct EpiLnBf16 {
    static constexpr bool PERM = true, AFTER_DRAIN = false;
    bf16_t* O; int ldc; const float* st; const float* c1; const float* c2;
    __device__ __forceinline__ void operator()(const f32x4 (&acc)[2][2][4][2], const Unit& u, int wr, int wc, int fr, int fq) const {
        const int row0 = u.pm * BM + wr * 64 + fr, col0 = u.pn * BM + wc * 32 + 8 * fq;
        f32x4 a1[2][2], a2[2][2];
#pragma unroll
        for (int bj = 0; bj < 2; ++bj)
#pragma unroll
            for (int n = 0; n < 2; ++n) { a1[bj][n] = *(const f32x4*)(c1 + col0 + bj * HALF + 4 * n); a2[bj][n] = *(const f32x4*)(c2 + col0 + bj * HALF + 4 * n); }
#pragma unroll
        for (int ai = 0; ai < 2; ++ai)
#pragma unroll
            for (int m = 0; m < 4; ++m) { const int row = row0 + ai * HALF + m * 16; bf16_t* rowp = O + (size_t)row * ldc + col0;
                float mn_, rs; row_stats(st, row, mn_, rs); const float rm = rs * mn_;
#pragma unroll
                for (int bj = 0; bj < 2; ++bj) { const f32x4 v0 = acc[ai][bj][m][0] * rs - a1[bj][0] * rm + a2[bj][0], v1 = acc[ai][bj][m][1] * rs - a1[bj][1] * rm + a2[bj][1];
                    u32x4 w; w.x = cvt_pk_bf16(v0[0], v0[1]); w.y = cvt_pk_bf16(v0[2], v0[3]); w.z = cvt_pk_bf16(v1[0], v1[1]); w.w = cvt_pk_bf16(v1[2], v1[3]);
                    *(u32x4*)(rowp + bj * HALF) = w; } }
    }
};
struct EpiSwiGLU {
    static constexpr bool PERM = true, AFTER_DRAIN = false;
    bf16_t* O; int ldc; const float* st; const float* c1; const float* c2;
    __device__ __forceinline__ void operator()(const f32x4 (&acc)[2][2][4][2], const Unit& u, int wr, int wc, int fr, int fq) const {
        const int row0 = u.pm * BM + wr * 64 + fr, col0 = u.pn * HALF + wc * 32 + 8 * fq, ccol = u.pn * BM + wc * 32 + 8 * fq;
        f32x2 a1[2][4], a2[2][4];
#pragma unroll
        for (int bj = 0; bj < 2; ++bj)
#pragma unroll
            for (int n = 0; n < 2; ++n) { const f32x4 x1 = *(const f32x4*)(c1 + ccol + bj * HALF + 4 * n), x2 = *(const f32x4*)(c2 + ccol + bj * HALF + 4 * n);
                a1[bj][2 * n] = lo2(x1); a1[bj][2 * n + 1] = hi2(x1); a2[bj][2 * n] = lo2(x2); a2[bj][2 * n + 1] = hi2(x2); }
#pragma unroll
        for (int ai = 0; ai < 2; ++ai)
#pragma unroll
            for (int m = 0; m < 4; ++m) { const int row = row0 + ai * HALF + m * 16; bf16_t* rowp = O + (size_t)row * ldc + col0;
                float mn_, rs; row_stats(st, row, mn_, rs); const f32x2 rs2 = sp2(rs), nrm2 = sp2(-rs * mn_);
                u32x4 w;
#pragma unroll
                for (int p = 0; p < 4; ++p) { const f32x4 ag = acc[ai][0][m][p >> 1], au = acc[ai][1][m][p >> 1]; const f32x2 g0 = (p & 1) ? hi2(ag) : lo2(ag), u0 = (p & 1) ? hi2(au) : lo2(au);
                    const f32x2 g = fma2(g0, rs2, fma2(a1[0][p], nrm2, a2[0][p])), uu = fma2(u0, rs2, fma2(a1[1][p], nrm2, a2[1][p]));
                    const f32x2 ge = g * sp2(-1.4426950408889634f); f32x2 e; e.x = __builtin_amdgcn_exp2f(ge.x); e.y = __builtin_amdgcn_exp2f(ge.y);
                    const f32x2 dn = e + sp2(1.0f); f32x2 sg; sg.x = __builtin_amdgcn_rcpf(dn.x); sg.y = __builtin_amdgcn_rcpf(dn.y);
                    const f32x2 r = (g * sg) * uu; w[p] = cvt_pk_bf16(r.x, r.y); }
                *(u32x4*)rowp = w; }
    }
};
template <bool RES_F32> struct EpiRes {
    static constexpr bool PERM = true, AFTER_DRAIN = false;
    const float* resf; const bf16_t* resb; const float* ist; const float* lw; const float* lb; bf16_t* out; float* ost; int ldc; float alpha;
    __device__ __forceinline__ void operator()(const f32x4 (&acc)[2][2][4][2], const Unit& u, int wr, int wc, int fr, int fq) const {
        const int rowu = u.pm * BM + wr * 64, col0 = u.pn * BM + wc * 32 + 8 * fq;
        const unsigned vb = (unsigned)(fr * ldc + col0) * 2u, vf = (unsigned)(fr * ldc + col0) * 4u;
        f32x2 wv[2][4], bv[2][4];
#pragma unroll
        for (int bj = 0; bj < 2; ++bj)
#pragma unroll
            for (int n = 0; n < 2; ++n) { f32x4 x1 = (f32x4){alpha, alpha, alpha, alpha}, x2 = (f32x4){0.f, 0.f, 0.f, 0.f};
                if (!RES_F32) { x1 = *(const f32x4*)(lw + col0 + bj * HALF + 4 * n) * alpha; x2 = *(const f32x4*)(lb + col0 + bj * HALF + 4 * n) * alpha; }
                wv[bj][2 * n] = lo2(x1); wv[bj][2 * n + 1] = hi2(x1); bv[bj][2 * n] = lo2(x2); bv[bj][2 * n + 1] = hi2(x2); }
        constexpr int RB = RES_F32 ? 2 : 4;
#pragma unroll
        for (int b0 = 0; b0 < 8; b0 += RB) {
            f32x4 rf[RB][2][2]; u32x4 rb[RB][2];
#pragma unroll
            for (int q = 0; q < RB; ++q) { const int ai = (b0 + q) >> 2, m = (b0 + q) & 3; const size_t rbase = (size_t)(rowu + ai * HALF + m * 16) * ldc;
#pragma unroll
                for (int bj = 0; bj < 2; ++bj) { if (RES_F32) { const char* p = (const char*)(resf + rbase + bj * HALF) + vf; rf[q][bj][0] = *(const f32x4*)p; rf[q][bj][1] = *(const f32x4*)(p + 16); }
                                                 else rb[q][bj] = *(const u32x4*)((const char*)(resb + rbase + bj * HALF) + vb); } }
#pragma unroll
            for (int q = 0; q < RB; ++q) { const int ai = (b0 + q) >> 2, m = (b0 + q) & 3; const int row = rowu + fr + ai * HALF + m * 16; const size_t rbase = (size_t)(rowu + ai * HALF + m * 16) * ldc;
                float mn = 0.f, rs = 1.f; if (!RES_F32) row_stats(ist, row, mn, rs);
                const f32x2 rs2 = sp2(rs), c02 = sp2(-mn * rs);
                f32x2 ps2 = sp2(0.f), pq2 = sp2(0.f);
#pragma unroll
                for (int bj = 0; bj < 2; ++bj) { u32x4 w;
#pragma unroll
                    for (int p = 0; p < 4; ++p) { f32x2 r;
                        if (RES_F32) { const f32x4 x = rf[q][bj][p >> 1]; r = (p & 1) ? hi2(x) : lo2(x); } else r = bf2(rb[q][bj][p]);
                        const f32x4 a4 = acc[ai][bj][m][p >> 1]; const f32x2 a = (p & 1) ? hi2(a4) : lo2(a4);
                        const f32x2 o = fma2(fma2(r, rs2, c02), wv[bj][p], bv[bj][p] + a);
                        w[p] = cvt_pk_bf16(o.x, o.y); ps2 = ps2 + o; pq2 = fma2(o, o, pq2); }
                    *(u32x4*)((char*)(out + rbase + bj * HALF) + vb) = w; }
                float ps = ps2.x + ps2.y, pq = pq2.x + pq2.y;
                ps += __shfl_xor(ps, 16); ps += __shfl_xor(ps, 32); pq += __shfl_xor(pq, 16); pq += __shfl_xor(pq, 32);
                if (fq == 0) { stat_add(ost + 2 * row, ps); stat_add(ost + 2 * row + 1, pq); } }
            asm volatile("" ::: "memory"); }
    }
};
struct EpiGlu {
    static constexpr bool PERM = true, AFTER_DRAIN = false;
    const bf16_t* Z; bf16_t* out; int ldc;
    __device__ __forceinline__ void operator()(const f32x4 (&acc)[2][2][4][2], const Unit& u, int wr, int wc, int fr, int fq) const {
        const int row0 = u.pm * BM + wr * 64 + fr, col0 = u.pn * BM + wc * 32 + 8 * fq;
#pragma unroll
        for (int ai = 0; ai < 2; ++ai)
#pragma unroll
            for (int m = 0; m < 4; ++m) { const size_t off = (size_t)(row0 + ai * HALF + m * 16) * ldc + col0;
#pragma unroll
                for (int bj = 0; bj < 2; ++bj) { const u32x4 zw = *(const u32x4*)(Z + off + bj * HALF); const f32x4 v0 = acc[ai][bj][m][0], v1 = acc[ai][bj][m][1];
                    u32x4 w;
                    w.x = cvt_pk_bf16(__uint_as_float(zw.x << 16) * sigm(v0[0]), __uint_as_float(zw.x & 0xffff0000u) * sigm(v0[1]));
                    w.y = cvt_pk_bf16(__uint_as_float(zw.y << 16) * sigm(v0[2]), __uint_as_float(zw.y & 0xffff0000u) * sigm(v0[3]));
                    w.z = cvt_pk_bf16(__uint_as_float(zw.z << 16) * sigm(v1[0]), __uint_as_float(zw.z & 0xffff0000u) * sigm(v1[1]));
                    w.w = cvt_pk_bf16(__uint_as_float(zw.w << 16) * sigm(v1[2]), __uint_as_float(zw.w & 0xffff0000u) * sigm(v1[3]));
                    *(u32x4*)(out + off + bj * HALF) = w; } }
    }
};
struct EpiPle {
    static constexpr bool PERM = true, AFTER_DRAIN = false;
    const bf16_t* resb; const float* ist; const float* lw; const float* lb; const float* c1; const float* c2; const bf16_t* PI; bf16_t* out; float* ost; int ldc; float alpha;
    __device__ __forceinline__ void operator()(const f32x4 (&acc)[2][2][4][2], const Unit& u, int wr, int wc, int fr, int fq) const {
        const int rowu = u.pm * BM + wr * 64, col0 = u.pn * BM + wc * 32 + 8 * fq; const unsigned vb = (unsigned)(fr * ldc + col0) * 2u;
        constexpr float NL = -1.4426950408889634f;
#pragma unroll
        for (int bj = 0; bj < 2; ++bj) {
            f32x2 k1[4], k2[4], wv[4], bv[4];
#pragma unroll
            for (int n = 0; n < 2; ++n) { const int cc = col0 + bj * HALF + 4 * n; const f32x4 x1 = *(const f32x4*)(c1 + cc), x2 = *(const f32x4*)(c2 + cc) * NL, x3 = *(const f32x4*)(lw + cc) * alpha, x4 = *(const f32x4*)(lb + cc) * alpha;
                k1[2 * n] = lo2(x1); k1[2 * n + 1] = hi2(x1); k2[2 * n] = lo2(x2); k2[2 * n + 1] = hi2(x2); wv[2 * n] = lo2(x3); wv[2 * n + 1] = hi2(x3); bv[2 * n] = lo2(x4); bv[2 * n + 1] = hi2(x4); }
#pragma unroll
            for (int hb = 0; hb < 4; ++hb) { const int ai = hb >> 1;
                u32x4 rwv[2], pwv[2];
#pragma unroll
                for (int mq = 0; mq < 2; ++mq) { const int m = (hb & 1) * 2 + mq; const size_t rbase = (size_t)(rowu + ai * HALF + m * 16) * ldc + bj * HALF; rwv[mq] = *(const u32x4*)((const char*)(resb + rbase) + vb); pwv[mq] = *(const u32x4*)((const char*)(PI + rbase) + vb); }
#pragma unroll
                for (int mq = 0; mq < 2; ++mq) { const int m = (hb & 1) * 2 + mq; const int row = rowu + fr + ai * HALF + m * 16; const size_t rbase = (size_t)(rowu + ai * HALF + m * 16) * ldc + bj * HALF; float mn, rs; row_stats(ist, row, mn, rs);
                    const f32x2 rs2 = sp2(rs), c02 = sp2(-mn * rs), rsl = sp2(rs * NL), rml = sp2(-rs * mn * NL);
                    u32x4 w; f32x2 ps2 = sp2(0.f), pq2 = sp2(0.f);
#pragma unroll
                    for (int p = 0; p < 4; ++p) { const f32x4 a4 = acc[ai][bj][m][p >> 1]; const f32x2 a = (p & 1) ? hi2(a4) : lo2(a4);
                        const f32x2 ge = fma2(a, rsl, fma2(k1[p], rml, k2[p])); f32x2 e; e.x = __builtin_amdgcn_exp2f(ge.x); e.y = __builtin_amdgcn_exp2f(ge.y);
                        const f32x2 dn = e + sp2(1.0f); f32x2 sg; sg.x = __builtin_amdgcn_rcpf(dn.x); sg.y = __builtin_amdgcn_rcpf(dn.y);
                        const f32x2 h = fma2(fma2(bf2(rwv[mq][p]), rs2, c02), wv[p], bv[p]);
                        const f32x2 o = fma2(bf2(pwv[mq][p]), sg, h);
                        w[p] = cvt_pk_bf16(o.x, o.y); ps2 = ps2 + o; pq2 = fma2(o, o, pq2); }
                    *(u32x4*)((char*)(out + rbase) + vb) = w;
                    float a = ps2.x + ps2.y, b = pq2.x + pq2.y;
                    a += __shfl_xor(a, 16); a += __shfl_xor(a, 32); b += __shfl_xor(b, 16); b += __shfl_xor(b, 32);
                    if (fq == 0) { stat_add(ost + 2 * row, a); stat_add(ost + 2 * row + 1, b); } }
                asm volatile("" ::: "memory"); }
        }
    }
};
template <class Epi, class Sched, bool ALIGN_EPI = false, bool SP2 = false>
__device__ __forceinline__ void gemm_phase(PG8_LAS unsigned char* lds, const Gemm g, const Sched& S, const Epi& E) {
    int tid_ = threadIdx.x; asm volatile("" : "+v"(tid_));
    const int tid = tid_, wid = __builtin_amdgcn_readfirstlane(tid >> 6), lane = tid & 63, wr = wid >> 2, wc = wid & 3, fr = lane & 15, fq = lane >> 4;
    const int K = g.K, nt = K / BK;
    unsigned voffA[2], voffB[2];
#pragma unroll
    for (int i = 0; i < 2; ++i) { int R, C; stage_rc(tid * 16 + i * 8192, R, C); const int Rb = Epi::PERM ? ((R & ~31) + perm32(R & 31)) : R;
        voffA[i] = (unsigned)(R * K + C) * 2u; voffB[i] = (unsigned)(Rb * K + C) * 2u; }
    const size_t kstep = (size_t)(BK * 2);
    const size_t hstep = (size_t)HALF * K * 2;
    const size_t tstep = 2 * hstep;
    const unsigned ldsw = (unsigned)wid * 1024u;
    const int aoff = lds_byte(wr * 64 + fr, fq * 8), boff = lds_byte(wc * 32 + fr, fq * 8);
#define PG8_SA(b, h) (((b) * 2 + (h)) * HTB)
#define PG8_SB(b, h) ((4 + (b) * 2 + (h)) * HTB)
#define PG8_STAGE(bufoff, gbase, voff) do { _Pragma("unroll") for (int _i = 0; _i < 2; ++_i) \
        __builtin_amdgcn_global_load_lds((const unsigned*)((const char*)(gbase) + (voff)[_i]), (PG8_LAS unsigned*)(lds + (bufoff) + ldsw + _i * 8192), 16, 0, 0); } while (0)
#define PG8_LDA(dst, b, h) do { _Pragma("unroll") for (int m = 0; m < 4; ++m) _Pragma("unroll") for (int k = 0; k < 2; ++k) dst[m][k] = *(const PG8_LAS bf16x8*)(lds + PG8_SA(b, h) + aoff + m * 2048 + k * 1024); } while (0)
#define PG8_LDB(dst, b, h) do { _Pragma("unroll") for (int n = 0; n < 2; ++n) _Pragma("unroll") for (int k = 0; k < 2; ++k) dst[n][k] = *(const PG8_LAS bf16x8*)(lds + PG8_SB(b, h) + boff + n * 2048 + k * 1024); } while (0)
#define PG8_MMA(ai, bj, At, Bt) do { __builtin_amdgcn_s_setprio(1); _Pragma("unroll") for (int m = 0; m < 4; ++m) _Pragma("unroll") for (int n = 0; n < 2; ++n) _Pragma("unroll") for (int k = 0; k < 2; ++k) \
        acc[ai][bj][m][n] = __builtin_amdgcn_mfma_f32_16x16x32_bf16(Bt[n][k], At[m][k], acc[ai][bj][m][n], 0, 0, 0); __builtin_amdgcn_s_setprio(0); } while (0)
#define PG8_WAIT_V(n) asm volatile("s_waitcnt vmcnt(" #n ")" ::: "memory")
#define PG8_WAIT_L(n) asm volatile("s_waitcnt lgkmcnt(" #n ")" ::: "memory")
#define PG8_BAR __builtin_amdgcn_s_barrier()
#define PG8_SCHED __builtin_amdgcn_sched_barrier(0)
    Unit cur, nxt; int ui = 0;
    if (!S.next(0, cur)) return;
    f32x4 acc[2][2][4][2];
#pragma unroll
    for (int a = 0; a < 2; ++a)
#pragma unroll
        for (int b = 0; b < 2; ++b)
#pragma unroll
            for (int m = 0; m < 4; ++m)
#pragma unroll
                for (int n = 0; n < 2; ++n) acc[a][b][m][n] = (f32x4){0.f, 0.f, 0.f, 0.f};
    bf16x8 At[4][2], B0[2][2], B1[2][2];
    const char* cA = (const char*)g.A + (size_t)cur.pm * tstep; const char* cB = (const char*)g.Bt + (size_t)cur.pn * tstep;
    S.a_ready(cur);
    if constexpr (SP2) {
        PG8_STAGE(PG8_SB(0, 0), cB, voffB); PG8_STAGE(PG8_SB(0, 1), cB + hstep, voffB); PG8_STAGE(PG8_SA(0, 0), cA, voffA); PG8_STAGE(PG8_SA(0, 1), cA + hstep, voffA);
        if (wr == 1) PG8_BAR;
        PG8_WAIT_V(2); PG8_BAR;
        PG8_STAGE(PG8_SB(1, 0), cB + kstep, voffB); PG8_STAGE(PG8_SA(1, 0), cA + kstep, voffA); PG8_STAGE(PG8_SB(1, 1), cB + hstep + kstep, voffB);
        PG8_WAIT_V(6); PG8_BAR;
    } else {
        PG8_STAGE(PG8_SB(0, 0), cB, voffB); PG8_STAGE(PG8_SA(0, 0), cA, voffA); PG8_STAGE(PG8_SB(0, 1), cB + hstep, voffB); PG8_STAGE(PG8_SA(0, 1), cA + hstep, voffA);
        if (wr == 1) PG8_BAR;
        PG8_WAIT_V(4); PG8_BAR;
        PG8_STAGE(PG8_SB(1, 0), cB + kstep, voffB); PG8_STAGE(PG8_SA(1, 0), cA + kstep, voffA); PG8_STAGE(PG8_SB(1, 1), cB + hstep + kstep, voffB);
        PG8_WAIT_V(6); PG8_BAR;
    }
    for (;;) {
        const bool has_next = S.next(ui + 1, nxt);
        const char* nA = has_next ? (const char*)g.A + (size_t)nxt.pm * tstep : cA; const char* nB = has_next ? (const char*)g.Bt + (size_t)nxt.pn * tstep : cB;
        for (int t = 0; t < nt; t += 2) {
            const bool last = (t == nt - 2);
            const char* a1 = cA + (size_t)(t + 1) * kstep;
            const char* a2 = last ? nA : cA + (size_t)(t + 2) * kstep; const char* b2 = last ? nB : cB + (size_t)(t + 2) * kstep;
            const char* a3 = a2 + kstep; const char* b3 = b2 + kstep;
            if (last && has_next) S.a_ready(nxt);
            if constexpr (SP2) {
            PG8_LDB(B0, 0, 0); PG8_LDB(B1, 0, 1); PG8_SCHED; PG8_LDA(At, 0, 0); PG8_STAGE(PG8_SA(1, 1), a1 + hstep, voffA);
            PG8_WAIT_V(8); PG8_WAIT_L(0); PG8_BAR; PG8_MMA(0, 0, At, B0); PG8_MMA(0, 1, At, B1); PG8_BAR; PG8_SCHED;
            PG8_LDA(At, 0, 1); PG8_STAGE(PG8_SB(0, 0), b2, voffB); PG8_STAGE(PG8_SB(0, 1), b2 + hstep, voffB); PG8_STAGE(PG8_SA(0, 0), a2, voffA);
            PG8_WAIT_V(8); PG8_WAIT_L(0); PG8_BAR; PG8_MMA(1, 0, At, B0); PG8_MMA(1, 1, At, B1); PG8_BAR; PG8_SCHED;
            PG8_LDB(B0, 1, 0); PG8_LDB(B1, 1, 1); PG8_SCHED; PG8_LDA(At, 1, 0); PG8_STAGE(PG8_SA(0, 1), a2 + hstep, voffA);
            PG8_WAIT_V(8); PG8_WAIT_L(0); PG8_BAR; PG8_MMA(0, 0, At, B0); PG8_MMA(0, 1, At, B1); PG8_BAR; PG8_SCHED;
            PG8_LDA(At, 1, 1); PG8_STAGE(PG8_SB(1, 0), b3, voffB); PG8_STAGE(PG8_SB(1, 1), b3 + hstep, voffB); PG8_STAGE(PG8_SA(1, 0), a3, voffA);
            PG8_WAIT_V(8); PG8_WAIT_L(0); PG8_BAR; PG8_MMA(1, 0, At, B0); PG8_MMA(1, 1, At, B1); PG8_BAR; PG8_SCHED;
            } else {
            PG8_LDB(B0, 0, 0); PG8_SCHED; PG8_LDA(At, 0, 0); PG8_STAGE(PG8_SA(1, 1), a1 + hstep, voffA);
            PG8_WAIT_L(8); PG8_BAR; PG8_WAIT_L(0); PG8_MMA(0, 0, At, B0); PG8_BAR; PG8_SCHED;
            PG8_LDB(B1, 0, 1); PG8_STAGE(PG8_SB(0, 0), b2, voffB);
            PG8_BAR; PG8_WAIT_L(0); PG8_MMA(0, 1, At, B1); PG8_BAR;
            PG8_LDA(At, 0, 1); PG8_STAGE(PG8_SA(0, 0), a2, voffA);
            PG8_BAR; PG8_WAIT_L(0); PG8_MMA(1, 0, At, B0); PG8_BAR; PG8_SCHED;
            PG8_STAGE(PG8_SB(0, 1), b2 + hstep, voffB);
            PG8_WAIT_V(6); PG8_BAR; PG8_MMA(1, 1, At, B1); PG8_BAR;
            PG8_LDB(B0, 1, 0); PG8_SCHED; PG8_LDA(At, 1, 0); PG8_STAGE(PG8_SA(0, 1), a2 + hstep, voffA);
            PG8_WAIT_L(8); PG8_BAR; PG8_WAIT_L(0); PG8_MMA(0, 0, At, B0); PG8_BAR; PG8_SCHED;
            PG8_LDB(B1, 1, 1); PG8_STAGE(PG8_SB(1, 0), b3, voffB);
            PG8_BAR; PG8_WAIT_L(0); PG8_MMA(0, 1, At, B1); PG8_BAR;
            PG8_LDA(At, 1, 1); PG8_STAGE(PG8_SA(1, 0), a3, voffA);
            PG8_BAR; PG8_WAIT_L(0); PG8_MMA(1, 0, At, B0); PG8_BAR; PG8_SCHED;
            PG8_STAGE(PG8_SB(1, 1), b3 + hstep, voffB);
            PG8_WAIT_V(6); PG8_BAR; PG8_MMA(1, 1, At, B1); PG8_BAR;
            }
        }
        if constexpr (ALIGN_EPI) { if (wr == 0) PG8_BAR; }
        if constexpr (!Epi::AFTER_DRAIN) { E(acc, cur, wr, wc, fr, fq); S.done(cur); }
        if (!has_next) break;
#pragma unroll
        for (int a = 0; a < 2; ++a)
#pragma unroll
            for (int b = 0; b < 2; ++b)
#pragma unroll
                for (int m = 0; m < 4; ++m)
#pragma unroll
                    for (int n = 0; n < 2; ++n) acc[a][b][m][n] = (f32x4){0.f, 0.f, 0.f, 0.f};
        cur = nxt; cA = nA; cB = nB; ++ui;
        if constexpr (ALIGN_EPI) { if (wr == 1) PG8_BAR; }
    }
    PG8_WAIT_V(0);
    if constexpr (!ALIGN_EPI) { if (wr == 0) PG8_BAR; }
    PG8_BAR;
    if constexpr (Epi::AFTER_DRAIN) { E.fused(acc, cur, wr, wc, fr, fq, lds, wid, lane); S.done(cur); }
#undef PG8_SA
#undef PG8_SB
#undef PG8_STAGE
#undef PG8_LDA
#undef PG8_LDB
#undef PG8_MMA
#undef PG8_WAIT_V
#undef PG8_WAIT_L
#undef PG8_BAR
#undef PG8_SCHED
}
}
#ifndef PROBE_SPAN
#define PROBE_SPAN 0
#endif
constexpr int NWAVES = 8;
constexpr int D = 4096, BATCH = 4, SEQ = 4096, M = BATCH * SEQ, DEPTH = 2;
constexpr int S5W = 1024, SGW = 1024, HGW = 2048, PROJ = 11264, DFF = 11008, PLE = 256;
constexpr int C_XA = 0, C_U = 1024, C_V = 2048, C_Q = 3072, C_F = 5120, C_I = 7168, C_G = 9216;
constexpr float LN_EPS = 1e-5f, RMS_EPS = 1e-6f;
constexpr float ALPHA = 1.4142135623730951f;
enum { I_X = 0, I_P, I_WIN, I_LAMRE, I_LAMIM, I_LOGSTEP, I_BRE, I_BIM, I_CRE, I_CIM, I_S5D, I_WGLU, I_SGLNW, I_SGLNB, I_SGW, I_SGB, I_HGLB, I_HGNW, I_NAW, I_NBW, I_WOUT, I_LN1W, I_LN1B,
       I_WFI, I_WFO, I_LN2W, I_LN2B, I_WPI, I_WPG, I_LN3W, I_LN3B, N_IN };
constexpr size_t MiB = 1u << 20;
constexpr size_t WS_CTL = 0, CTL_ZERO_BYTES = 2 * MiB;
constexpr size_t CTL_STATS = 64 * 1024, STATS_BYTES = (size_t)16384 * 2 * 4;
constexpr size_t CTL_CVEC = CTL_STATS + 6 * STATS_BYTES;
constexpr int CV_IN = 0, CV_FI = 11264, CV_PG = 11264 + 22016, CV_N = 11264 + 22016 + 4096;
static_assert(CTL_CVEC + (size_t)2 * 2 * CV_N * 4 <= CTL_ZERO_BYTES, "control region");
constexpr size_t WS_CVP_ = (size_t)(2258 + 1 + 32 + 32 + 16 + 16) * MiB;
constexpr int CV_KB = 64;

constexpr size_t WS_W = 2 * MiB, WL_STRIDE = 416 * MiB;
constexpr size_t WO_IN = 0, WO_GLU = 88 * MiB, WO_OUT = 90 * MiB, WO_FI = 122 * MiB, WO_FO = 294 * MiB, WO_PI = 380 * MiB, WO_PG = 382 * MiB;
constexpr size_t WS_PB = WS_W + 2 * WL_STRIDE;
constexpr size_t WS_HF = WS_PB + 16 * MiB;
constexpr size_t WS_HB = WS_HF + 256 * MiB;
constexpr size_t WS_T = WS_HB + 128 * MiB;
constexpr size_t WS_PROJ = WS_T + 256 * MiB;
constexpr size_t WS_CAT = WS_PROJ + 352 * MiB;
constexpr size_t WS_Z = WS_CAT + 128 * MiB;
constexpr size_t WS_ZA = WS_Z + 32 * MiB;
constexpr size_t WS_UZ = WS_ZA + 64 * MiB;
constexpr size_t WS_O = WS_UZ + 64 * MiB;
constexpr size_t WS_STAT = WS_O + 128 * MiB;
constexpr size_t WS_LNS = WS_STAT + 512 * 1024;
constexpr size_t WS_END = WS_STAT + 1 * MiB;
constexpr int CW_BAR = 4096;
constexpr int CW_TEAM = 12288;
constexpr int CW_GRP = 8192;

constexpr int RING_OFF = 0, RING_BYTES = 131072;
constexpr int LDSCTL_OFF = RING_BYTES, MISC_OFF = LDSCTL_OFF + 320;
constexpr int STATL_OFF = 147456;
constexpr int LDS_BYTES = 163840;
#define GAS __attribute__((address_space(1)))
#define LAS __attribute__((address_space(3)))
typedef unsigned short bf16;
typedef unsigned v4u __attribute__((ext_vector_type(4)));
typedef float f32x4 __attribute__((ext_vector_type(4)));
typedef short bf16x8 __attribute__((ext_vector_type(8)));
typedef GAS unsigned gu32;
typedef GAS unsigned long long gu64;
#define RLX_AGENT __ATOMIC_RELAXED, __HIP_MEMORY_SCOPE_AGENT
#define LDS_WAIT() asm volatile("s_waitcnt lgkmcnt(0)" ::: "memory")
#define VM_WAIT() asm volatile("s_waitcnt vmcnt(0)" ::: "memory")
__device__ __forceinline__ unsigned long long rt() { return __builtin_amdgcn_s_memrealtime(); }
typedef float f32x2_t __attribute__((ext_vector_type(2)));
typedef __bf16 bf16x2_t __attribute__((ext_vector_type(2)));
__device__ __forceinline__ unsigned pk2(float lo, float hi) { const f32x2_t v = {lo, hi}; return __builtin_bit_cast(unsigned, __builtin_convertvector(v, bf16x2_t)); }
__device__ __forceinline__ unsigned f2bf(float f) { return pk2(f, 0.f) & 0xffffu; }

#define XB_TMO      128
#define XB_XCNT(j)  (256  + 64 * (j))
#define XB_XSUB(j)  (1280 + 64 * (j))
#define XB_XGEN(j)  (2304 + 64 * (j))
#define XB_TOP      3328
#define XB_TOPGEN   3392
#define XCD_BAR_WORDS 3456
#define XB_SPIN_CAP (1u << 18)

__device__ __forceinline__ unsigned xb_ld(unsigned* p)              { return __hip_atomic_load(p, __ATOMIC_RELAXED, __HIP_MEMORY_SCOPE_AGENT); }
__device__ __forceinline__ unsigned xb_add(unsigned* p, unsigned v) { return __hip_atomic_fetch_add(p, v, __ATOMIC_RELAXED, __HIP_MEMORY_SCOPE_AGENT); }
__device__ __forceinline__ unsigned xb_xcc_id() { return (unsigned)__builtin_amdgcn_s_getreg((3 << 11) | 20) & 0xFu; }
#define XB_SPIN(cond, bar) do { unsigned _sp = 0; while (cond) { __builtin_amdgcn_s_sleep(1); \
    if ((++_sp & 255u) == 0u) { if (xb_ld(&(bar)[XB_TMO])) break; if (_sp > XB_SPIN_CAP) { atomicAdd(&(bar)[XB_TMO], 1u); break; } } } } while (0)

struct XcdBarrier {
    unsigned* bar; unsigned x;
    volatile LAS unsigned* st;
};

__device__ __forceinline__ XcdBarrier xcd_barrier_post(unsigned* bar, volatile LAS unsigned* st) {
    XcdBarrier b; b.bar = bar; b.x = xb_xcc_id(); b.st = st;
    if (threadIdx.x == 0) (void)xb_add(&bar[XB_XCNT(b.x)], 1u);
    return b;
}
__device__ __forceinline__ void xcd_barrier_complete(unsigned* bar, unsigned x, unsigned& nloc, unsigned& nx) {
    const unsigned G = gridDim.x * gridDim.y * gridDim.z;
    unsigned sum, cnt, mine, sp = 0u;
    for (;;) {
        sum = 0u; cnt = 0u; mine = 0u;
#pragma unroll
        for (unsigned j = 0; j < 16; ++j) { const unsigned c = xb_ld(&bar[XB_XCNT(j)]); sum += c; cnt += (c > 0u) ? 1u : 0u; mine = (j == x) ? c : mine; }
        if (sum == G) break;
        __builtin_amdgcn_s_sleep(1);
        if ((++sp & 255u) == 0u) { if (xb_ld(&bar[XB_TMO])) break; if (sp > XB_SPIN_CAP) { atomicAdd(&bar[XB_TMO], 1u); break; } }
    }
    nloc = mine > 0u ? mine : 1u; nx = cnt > 0u ? cnt : 1u;
}

__device__ __forceinline__ void xcd_barrier(const XcdBarrier& b) {
    asm volatile("s_waitcnt vmcnt(0)" ::: "memory");
    __syncthreads();
    if (threadIdx.x == 0) {
        unsigned* bar = b.bar; const unsigned bx = xb_xcc_id();
        __builtin_amdgcn_s_waitcnt(0);
        unsigned nloc = b.st[0], nx = b.st[1];
        if (nloc == 0u) { xcd_barrier_complete(bar, bx, nloc, nx); b.st[0] = nloc; b.st[1] = nx; }
        const unsigned old = xb_add(&bar[XB_XSUB(bx)], 1u);
        const unsigned gen = old / nloc;
        if (old + 1u == (gen + 1u) * nloc) {
            __builtin_amdgcn_fence(__ATOMIC_RELEASE, "agent");
            asm volatile("s_waitcnt vmcnt(0)" ::: "memory");
            const unsigned og = xb_add(&bar[XB_TOP], 1u);
            const unsigned tg = og / nx;
            if (og + 1u == (tg + 1u) * nx) xb_add(&bar[XB_TOPGEN], 1u);
            else XB_SPIN(xb_ld(&bar[XB_TOPGEN]) == tg, bar);
            __builtin_amdgcn_fence(__ATOMIC_ACQUIRE, "agent");
            xb_add(&bar[XB_XGEN(bx)], 1u);
            asm volatile("s_waitcnt vmcnt(0)" ::: "memory");
        } else {
            XB_SPIN(xb_ld(&bar[XB_XGEN(bx)]) == gen, bar);
            __builtin_amdgcn_fence(__ATOMIC_ACQUIRE, "agent");
            asm volatile("s_waitcnt vmcnt(0)" ::: "memory");
        }
    }
    __syncthreads();
}


__device__ __forceinline__ void grp_barrier(unsigned* cnt  , unsigned nmem, unsigned* tmo) {
    asm volatile("s_waitcnt vmcnt(0)" ::: "memory");
    __syncthreads();
    if (threadIdx.x == 0) {
        __builtin_amdgcn_s_waitcnt(0);
        const unsigned old = xb_add(cnt, 1u); const unsigned target = (old / nmem + 1u) * nmem;
        XB_SPIN(xb_ld(cnt) < target, tmo);
        __builtin_amdgcn_fence(__ATOMIC_ACQUIRE, "agent");
        asm volatile("s_waitcnt vmcnt(0)" ::: "memory");
    }
    __syncthreads();
}
struct KArgs { const float* in[N_IN]; float* out; unsigned char* ws; unsigned long long rep; int ph_lo, ph_hi; };
constexpr int ARGTAB_OFF = LDSCTL_OFF + 1024;
struct InTab { LAS const unsigned* t;
    __device__ __forceinline__ const float* operator[](int i) const { const unsigned lo = t[2 * i], hi = t[2 * i + 1];
        return (const float*)(((unsigned long long)(unsigned)__builtin_amdgcn_readfirstlane((int)hi) << 32) | (unsigned)__builtin_amdgcn_readfirstlane((int)lo)); } };
struct Args { InTab in; float* out; unsigned char* ws; unsigned long long rep; int ph_lo, ph_hi; };
struct Frame {
    LAS unsigned char* lds;
    int wave, vcu, G;
    unsigned long long pr_acc; bool pr_me;
};
#define LDS_BARRIER() do { asm volatile("s_waitcnt lgkmcnt(0)" ::: "memory"); __builtin_amdgcn_s_barrier(); asm volatile("" ::: "memory"); } while (0)
__device__ __forceinline__ int lane_now() { int l = (int)__builtin_amdgcn_mbcnt_hi(~0u, __builtin_amdgcn_mbcnt_lo(~0u, 0u)); asm volatile("" : "+v"(l)); return l; }
__device__ __forceinline__ int bid_now() { int b = (int)blockIdx.x; asm volatile("" : "+s"(b)); return b; }
__device__ __forceinline__ int opaque(int v) { asm volatile("" : "+v"(v)); return v; }
__device__ __forceinline__ int tid_now(const Frame& F) { return F.wave * 64 + lane_now(); }
__device__ __forceinline__ float wave_sum(float v) {
#pragma unroll
    for (int o = 1; o < 64; o <<= 1) v += __shfl_xor(v, o);
    return v;
}
__device__ __forceinline__ float bflo(unsigned w) { return __uint_as_float(w << 16); }
__device__ __forceinline__ float bfhi(unsigned w) { return __uint_as_float(w & 0xffff0000u); }
__device__ __forceinline__ float bf1(bf16 h) { return __uint_as_float(((unsigned)h) << 16); }
__device__ __forceinline__ float sigmoid_f(float x) { return __builtin_amdgcn_rcpf(1.0f + __builtin_amdgcn_exp2f(-1.4426950408889634f * x)); }
__device__ __forceinline__ float silu_f(float x) { return x * sigmoid_f(x); }
__device__ __forceinline__ float gelu_f(float x) { const float x2 = x * x; const float a2 = x * (-2.302208198f - 0.102943240f * x2);
    return x * __builtin_amdgcn_rcpf(1.0f + __builtin_amdgcn_exp2f(a2)); }

struct P0Item { const float* W; bf16* WT; int K, N, swz, r; const float* lnw; const float* lnb; float* c1; float* c2; };
__device__ __forceinline__ P0Item p0_item(const Args& A, int it) {
    constexpr int IT_IN = (D / 64) * (PROJ / 32), IT_GLU = (S5W / 64) * (S5W / 32), IT_OUT = (D / 64) * (D / 32), IT_FI = (D / 64) * (2 * DFF / 32), IT_FO = (DFF / 64) * (D / 32), IT_PI = (PLE / 64) * (D / 32), IT_PG = IT_OUT;
    constexpr int IT_L = IT_IN + IT_GLU + IT_OUT + IT_FI + IT_FO + IT_PI + IT_PG;
    const int l = it / IT_L; int r = it % IT_L; unsigned char* wl = A.ws + WS_W + (size_t)l * WL_STRIDE; P0Item I;
    float* cv = (float*)(A.ws + WS_CVP_) + (size_t)l * CV_KB * 2 * CV_N; const float* nul = nullptr; float* nulw = nullptr;
    if (r < IT_IN) { I = P0Item{A.in[I_WIN] + (size_t)l * D * PROJ, (bf16*)(wl + WO_IN), D, PROJ, 0, r, l ? A.in[I_LN3W] + (l - 1) * D : nul, l ? A.in[I_LN3B] + (l - 1) * D : nul, l ? cv + CV_IN : nulw, l ? cv + CV_N + CV_IN : nulw}; return I; } r -= IT_IN;
    if (r < IT_GLU) { I = P0Item{A.in[I_WGLU] + (size_t)l * S5W * S5W, (bf16*)(wl + WO_GLU), S5W, S5W, 0, r, nul, nul, nulw, nulw}; return I; } r -= IT_GLU;
    if (r < IT_OUT) { I = P0Item{A.in[I_WOUT] + (size_t)l * D * D, (bf16*)(wl + WO_OUT), D, D, 0, r, nul, nul, nulw, nulw}; return I; } r -= IT_OUT;
    if (r < IT_FI) { I = P0Item{A.in[I_WFI] + (size_t)l * D * 2 * DFF, (bf16*)(wl + WO_FI), D, 2 * DFF, 1, r, A.in[I_LN1W] + l * D, A.in[I_LN1B] + l * D, cv + CV_FI, cv + CV_N + CV_FI}; return I; } r -= IT_FI;
    if (r < IT_FO) { I = P0Item{A.in[I_WFO] + (size_t)l * DFF * D, (bf16*)(wl + WO_FO), DFF, D, 0, r, nul, nul, nulw, nulw}; return I; } r -= IT_FO;
    if (r < IT_PI) { I = P0Item{A.in[I_WPI] + (size_t)l * PLE * D, (bf16*)(wl + WO_PI), PLE, D, 0, r, nul, nul, nulw, nulw}; return I; } r -= IT_PI;
    I = P0Item{A.in[I_WPG] + (size_t)l * D * D, (bf16*)(wl + WO_PG), D, D, 0, r, A.in[I_LN2W] + l * D, A.in[I_LN2B] + l * D, cv + CV_PG, cv + CV_N + CV_PG}; return I;
}
__device__ __forceinline__ void p0_load(const P0Item& I, int lane, float (&rg)[32]) {
    const int nblk = I.N / 32, kb = I.r / nblk, nb = I.r % nblk; const float* p = I.W + (size_t)(64 * kb + (lane >> 5)) * I.N + 32 * nb + (lane & 31);
#pragma unroll
    for (int i = 0; i < 32; ++i) rg[i] = p[(size_t)(2 * i) * I.N];
}
__device__ __forceinline__ void p0_store(const P0Item& I, int lane, const float (&rg)[32], LAS float* scr) {
    const int nblk = I.N / 32, kb = I.r / nblk, nb = I.r % nblk, k0 = 64 * kb, n0 = 32 * nb;
#pragma unroll
    for (int i = 0; i < 32; ++i) scr[(2 * i + (lane >> 5)) * 33 + (lane & 31)] = rg[i];
    LDS_WAIT(); asm volatile("" ::: "memory");
    const int c = lane & 7;
    int r0 = n0;
    if (I.swz) { r0 = (n0 < DFF) ? (n0 / 128) * 256 + (n0 % 128) : ((n0 - DFF) / 128) * 256 + 128 + ((n0 - DFF) % 128); }
    f32x4 g0 = (f32x4){1.f, 1.f, 1.f, 1.f}, g1 = g0, h0 = (f32x4){0.f, 0.f, 0.f, 0.f}, h1 = h0;
    if (I.lnw) { g0 = *(const f32x4*)(I.lnw + k0 + 8 * c); g1 = *(const f32x4*)(I.lnw + k0 + 8 * c + 4); h0 = *(const f32x4*)(I.lnb + k0 + 8 * c); h1 = *(const f32x4*)(I.lnb + k0 + 8 * c + 4); }
#pragma unroll
    for (int j = 0; j < 4; ++j) { const int n = (lane >> 3) + 8 * j; const LAS float* s = scr + (8 * c) * 33 + n;
        const float w0 = s[0 * 33], w1 = s[1 * 33], w2 = s[2 * 33], w3 = s[3 * 33], w4 = s[4 * 33], w5 = s[5 * 33], w6 = s[6 * 33], w7 = s[7 * 33];
        v4u o; o.x = pk2(w0 * g0[0], w1 * g0[1]); o.y = pk2(w2 * g0[2], w3 * g0[3]); o.z = pk2(w4 * g1[0], w5 * g1[1]); o.w = pk2(w6 * g1[2], w7 * g1[3]);
        *(GAS v4u*)(I.WT + (size_t)(r0 + n) * I.K + k0 + 8 * c) = o;
        if (I.lnw) {
            float s1 = ((bflo(o.x) + bfhi(o.x)) + (bflo(o.y) + bfhi(o.y))) + ((bflo(o.z) + bfhi(o.z)) + (bflo(o.w) + bfhi(o.w)));
            float s2 = ((w0 * h0[0] + w1 * h0[1]) + (w2 * h0[2] + w3 * h0[3])) + ((w4 * h1[0] + w5 * h1[1]) + (w6 * h1[2] + w7 * h1[3]));
            s1 += __shfl_xor(s1, 1); s1 += __shfl_xor(s1, 2); s1 += __shfl_xor(s1, 4); s2 += __shfl_xor(s2, 1); s2 += __shfl_xor(s2, 2); s2 += __shfl_xor(s2, 4);
            if (c == 0) { I.c1[(size_t)kb * 2 * CV_N + r0 + n] = s1; I.c2[(size_t)kb * 2 * CV_N + r0 + n] = s2; } } }
    LDS_WAIT(); asm volatile("" ::: "memory");
}
__device__ __forceinline__ void p0_prologue(const Args& A, Frame& F) {
    LAS float* scr = (LAS float*)(F.lds + RING_OFF + F.wave * 16384);
    const int gw = F.vcu * NWAVES + F.wave, NGW = F.G * NWAVES; const int lane = lane_now();
    constexpr int IT_IN = (D / 64) * (PROJ / 32), IT_GLU = (S5W / 64) * (S5W / 32), IT_OUT = (D / 64) * (D / 32), IT_FI = (D / 64) * (2 * DFF / 32), IT_FO = (DFF / 64) * (D / 32), IT_PI = (PLE / 64) * (D / 32), IT_PG = IT_OUT;
    constexpr int NIT = DEPTH * (IT_IN + IT_GLU + IT_OUT + IT_FI + IT_FO + IT_PI + IT_PG);
    int it = gw, itEnd = NIT, stride = NGW;
    if (F.G == 256) { constexpr int NB = DEPTH * 64, NITA = (int)(0.5160 * NIT);
        if (F.vcu >= NB) { it = (F.vcu - NB) * NWAVES + F.wave; itEnd = NITA; stride = (F.G - NB) * NWAVES; } else { it = NITA + gw; itEnd = NIT; stride = NB * NWAVES; } }
    {   float ra[32], rb[32];
        if (it < itEnd) { P0Item I0 = p0_item(A, it); p0_load(I0, lane, ra);
            for (;;) {
                const int it1 = it + stride; P0Item I1 = I0; if (it1 < itEnd) { I1 = p0_item(A, it1); p0_load(I1, lane, rb); }
                p0_store(I0, lane, ra, scr);
                if (it1 >= itEnd) break;
                const int it2 = it1 + stride; if (it2 < itEnd) { I0 = p0_item(A, it2); p0_load(I0, lane, ra); }
                p0_store(I1, lane, rb, scr);
                if (it2 >= itEnd) break;
                it = it2;
            } }
    }
    { const float* x = A.in[I_X]; bf16* hb = (bf16*)(A.ws + WS_HB); const size_t n8 = (size_t)M * D / 8;
#pragma unroll 4
      for (size_t i = (size_t)gw * 64 + lane; i < n8; i += (size_t)NGW * 64) { const f32x4 a = *(const f32x4*)(x + i * 8), b = *(const f32x4*)(x + i * 8 + 4);
          v4u o; o.x = pk2(a[0], a[1]); o.y = pk2(a[2], a[3]); o.z = pk2(b[0], b[1]); o.w = pk2(b[2], b[3]); *(v4u*)(hb + i * 8) = o; } }
    { const float* p = A.in[I_P]; bf16* pb = (bf16*)(A.ws + WS_PB); const size_t n8 = (size_t)DEPTH * M * PLE / 8;
#pragma unroll 4
      for (size_t i = (size_t)gw * 64 + lane; i < n8; i += (size_t)NGW * 64) { const f32x4 a = *(const f32x4*)(p + i * 8), b = *(const f32x4*)(p + i * 8 + 4);
          v4u o; o.x = pk2(a[0], a[1]); o.y = pk2(a[2], a[3]); o.z = pk2(b[0], b[1]); o.w = pk2(b[2], b[3]); *(v4u*)(pb + i * 8) = o; } }
}

__device__ __forceinline__ void stats_to_lds(Frame& F, const float* st) {
    typedef float f32x2l __attribute__((ext_vector_type(2)));
    const int tid = tid_now(F), x = bid_now() & 7; LAS f32x2l* T = (LAS f32x2l*)(F.lds + STATL_OFF);
#pragma unroll
    for (int i = 0; i < 4; ++i) { const int r = tid + 512 * i; const f32x2l v = *(const f32x2l*)(st + 2 * (size_t)(2048 * x + r));
        const float mean = v[0] * (1.0f / D), var = fmaxf(v[1] * (1.0f / D) - mean * mean, 0.f); T[r] = (f32x2l){mean, 1.0f / sqrtf(var + LN_EPS)}; }
    __syncthreads();
}
__device__ __forceinline__ void cvec_reduce(const Args& A, int gw, int NGW, int lane) {
    const float* P = (const float*)(A.ws + WS_CVP_); float* C = (float*)(A.ws + WS_CTL + CTL_CVEC);
    for (int i = gw * 64 + lane; i < DEPTH * 2 * CV_N; i += NGW * 64) { const int l = i / (2 * CV_N), r = i % (2 * CV_N); const float* p = P + (size_t)l * CV_KB * 2 * CV_N + r; float s = 0.f;
#pragma unroll
        for (int kb = 0; kb < CV_KB; ++kb) s += p[(size_t)kb * 2 * CV_N];
        C[i] = s; }
}

__device__ __forceinline__ void ln_phase(Frame& F, const bf16* T, const float* w, const float* b, float* outF, bf16* outB, float* stats) {
    const int gw = F.vcu * NWAVES + F.wave, NGW = F.G * NWAVES; const int lane = lane_now(), tid = tid_now(F);
    LAS f32x4* WL4 = (LAS f32x4*)(F.lds + RING_OFF); LAS f32x4* BL4 = WL4 + D / 4;
    for (int i = tid; i < D / 4; i += NWAVES * 64) { WL4[i] = ((const f32x4*)w)[i]; BL4[i] = ((const f32x4*)b)[i]; }
    __syncthreads();
    v4u rc[8], rn[8];
    int m = gw;
    if (m < M) {
#pragma unroll
        for (int j = 0; j < 8; ++j) rc[j] = *(const v4u*)(T + (size_t)m * D + 512 * j + 8 * lane);
    }
    while (m < M) {
        const int mn = m + NGW;
        if (mn < M) {
#pragma unroll
            for (int j = 0; j < 8; ++j) rn[j] = *(const v4u*)(T + (size_t)mn * D + 512 * j + 8 * lane);
        }
        float v[8][8]; float s = 0.f;
#pragma unroll
        for (int j = 0; j < 8; ++j) { v[j][0] = bflo(rc[j].x); v[j][1] = bfhi(rc[j].x); v[j][2] = bflo(rc[j].y); v[j][3] = bfhi(rc[j].y); v[j][4] = bflo(rc[j].z); v[j][5] = bfhi(rc[j].z); v[j][6] = bflo(rc[j].w); v[j][7] = bfhi(rc[j].w);
            s += ((v[j][0] + v[j][1]) + (v[j][2] + v[j][3])) + ((v[j][4] + v[j][5]) + (v[j][6] + v[j][7])); }
        const float mean = wave_sum(s) * (1.f / D); float s2 = 0.f;
#pragma unroll
        for (int j = 0; j < 8; ++j)
#pragma unroll
            for (int e = 0; e < 8; ++e) { v[j][e] -= mean; s2 += v[j][e] * v[j][e]; }
        const float rstd = 1.f / sqrtf(wave_sum(s2) * (1.f / D) + LN_EPS);
        if (stats && lane == 0) { stats[2 * m] = mean; stats[2 * m + 1] = rstd; }
        int lo = lane; asm volatile("" : "+v"(lo));
#pragma unroll
        for (int j = 0; j < 8; ++j) { const f32x4 w0 = WL4[128 * j + 2 * lo], w1 = WL4[128 * j + 2 * lo + 1], b0 = BL4[128 * j + 2 * lo], b1 = BL4[128 * j + 2 * lo + 1];
            float y[8];
#pragma unroll
            for (int e = 0; e < 4; ++e) { y[e] = v[j][e] * rstd * w0[e] + b0[e]; y[4 + e] = v[j][4 + e] * rstd * w1[e] + b1[e]; }
            if (outF) { *(f32x4*)(outF + (size_t)m * D + 512 * j + 8 * lane) = (f32x4){y[0], y[1], y[2], y[3]}; *(f32x4*)(outF + (size_t)m * D + 512 * j + 8 * lane + 4) = (f32x4){y[4], y[5], y[6], y[7]}; }
            if (outB) { v4u o; o.x = pk2(y[0], y[1]); o.y = pk2(y[2], y[3]); o.z = pk2(y[4], y[5]); o.w = pk2(y[6], y[7]); *(v4u*)(outB + (size_t)m * D + 512 * j + 8 * lane) = o; } }
#pragma unroll
        for (int j = 0; j < 8; ++j) rc[j] = rn[j];
        m = mn;
    }
    __syncthreads();
}

__device__ __forceinline__ void unpack8(const v4u w, float (&v)[8]) { v[0] = bflo(w.x); v[1] = bfhi(w.x); v[2] = bflo(w.y); v[3] = bfhi(w.y); v[4] = bflo(w.z); v[5] = bfhi(w.z); v[6] = bflo(w.w); v[7] = bfhi(w.w); }
__device__ __forceinline__ v4u pack8(const float (&v)[8]) { v4u o; o.x = pk2(v[0], v[1]); o.y = pk2(v[2], v[3]); o.z = pk2(v[4], v[5]); o.w = pk2(v[6], v[7]); return o; }
__device__ __forceinline__ void norm_phase(const Args& A, Frame& F, int l) {
    const bool grp = (F.G == 256); const int lane = lane_now(); const int pbase = 256 * (8 * (int)(blockIdx.x & 7u) + (int)((blockIdx.x >> 3) & 7u));
    const int gw = grp ? pbase + ((int)(blockIdx.x >> 6) * NWAVES + F.wave) : F.vcu * NWAVES + F.wave, NGW = grp ? 32 : F.G * NWAVES, MEND = grp ? pbase + 256 : M;
    const bf16* za = (const bf16*)(A.ws + WS_ZA); const bf16* uz = (const bf16*)(A.ws + WS_UZ); const bf16* o = (const bf16*)(A.ws + WS_O);
    const bf16* proj = (const bf16*)(A.ws + WS_PROJ); bf16* cat = (bf16*)(A.ws + WS_CAT);
    const float* naw = A.in[I_NAW] + l * S5W; const float* nbw = A.in[I_NBW] + l * SGW; const float* hnw = A.in[I_HGNW] + l * 128;
    v4u ra[2], ru[2], ro[4], rg[4], na[2], nu[2], no[4], ng[4];
#define NORM_LOAD(m_, a_, u_, o_, g_) do { _Pragma("unroll") for (int j = 0; j < 2; ++j) { a_[j] = *(const v4u*)(za + (size_t)(m_) * S5W + 512 * j + 8 * lane); u_[j] = *(const v4u*)(uz + (size_t)(m_) * SGW + 512 * j + 8 * lane); } \
        _Pragma("unroll") for (int j = 0; j < 4; ++j) { o_[j] = *(const v4u*)(o + (size_t)(m_) * HGW + 512 * j + 8 * lane); g_[j] = *(const v4u*)(proj + (size_t)(m_) * PROJ + C_G + 512 * j + 8 * lane); } } while (0)
    int m = gw; if (m < MEND) NORM_LOAD(m, ra, ru, ro, rg);
    while (m < MEND) {
        const int mn = m + NGW; if (mn < MEND) NORM_LOAD(mn, na, nu, no, ng);
        int lo = lane; asm volatile("" : "+v"(lo));
#pragma unroll
        for (int part = 0; part < 2; ++part) {
            const float* wv = part ? nbw : naw;
            float v[2][8]; float ss = 0.f;
#pragma unroll
            for (int j = 0; j < 2; ++j) { unpack8(part ? ru[j] : ra[j], v[j]);
#pragma unroll
                for (int e = 0; e < 8; ++e) ss += v[j][e] * v[j][e]; }
            const float r = 1.f / sqrtf(wave_sum(ss) * (1.f / 1024.f) + RMS_EPS);
#pragma unroll
            for (int j = 0; j < 2; ++j) { const f32x4 w0 = *(const f32x4*)(wv + 512 * j + 8 * lo), w1 = *(const f32x4*)(wv + 512 * j + 8 * lo + 4);
                float y[8];
#pragma unroll
                for (int e = 0; e < 4; ++e) { y[e] = v[j][e] * r * w0[e]; y[4 + e] = v[j][4 + e] * r * w1[e]; }
                *(v4u*)(cat + (size_t)m * D + part * S5W + 512 * j + 8 * lane) = pack8(y); }
        }
        const f32x4 hw0 = *(const f32x4*)(hnw + 8 * (lo & 15)), hw1 = *(const f32x4*)(hnw + 8 * (lo & 15) + 4);
#pragma unroll
        for (int j = 0; j < 4; ++j) {
            float v[8], gv[8]; unpack8(ro[j], v); unpack8(rg[j], gv);
            float ss = 0.f;
#pragma unroll
            for (int e = 0; e < 8; ++e) ss += v[e] * v[e];
#pragma unroll
            for (int sh = 1; sh < 16; sh <<= 1) ss += __shfl_xor(ss, sh);
            const float r = 1.f / sqrtf(ss * (1.f / 128.f) + RMS_EPS);
            float y[8];
#pragma unroll
            for (int e = 0; e < 4; ++e) { y[e] = v[e] * r * hw0[e] * silu_f(gv[e]); y[4 + e] = v[4 + e] * r * hw1[e] * silu_f(gv[4 + e]); }
            *(v4u*)(cat + (size_t)m * D + S5W + SGW + 512 * j + 8 * lane) = pack8(y);
        }
#pragma unroll
        for (int j = 0; j < 2; ++j) { ra[j] = na[j]; ru[j] = nu[j]; }
#pragma unroll
        for (int j = 0; j < 4; ++j) { ro[j] = no[j]; rg[j] = ng[j]; }
        m = mn;
    }
#undef NORM_LOAD
}
__device__ __forceinline__ void sgu_stats_phase(const Args& A, int gw, int NGW, int lane) {
    const bf16* proj = (const bf16*)(A.ws + WS_PROJ); float* st = (float*)(A.ws + WS_STAT);
    v4u rc[2], rn[2]; int m = gw;
    if (m < M) { rc[0] = *(const v4u*)(proj + (size_t)m * PROJ + C_V + 8 * lane); rc[1] = *(const v4u*)(proj + (size_t)m * PROJ + C_V + 512 + 8 * lane); }
    while (m < M) {
        const int mn = m + NGW;
        if (mn < M) { rn[0] = *(const v4u*)(proj + (size_t)mn * PROJ + C_V + 8 * lane); rn[1] = *(const v4u*)(proj + (size_t)mn * PROJ + C_V + 512 + 8 * lane); }
        float v[16];
#pragma unroll
        for (int j = 0; j < 2; ++j) { const v4u w = rc[j];
            v[8 * j + 0] = gelu_f(bflo(w.x)); v[8 * j + 1] = gelu_f(bfhi(w.x)); v[8 * j + 2] = gelu_f(bflo(w.y)); v[8 * j + 3] = gelu_f(bfhi(w.y));
            v[8 * j + 4] = gelu_f(bflo(w.z)); v[8 * j + 5] = gelu_f(bfhi(w.z)); v[8 * j + 6] = gelu_f(bflo(w.w)); v[8 * j + 7] = gelu_f(bfhi(w.w)); }
        float s = 0.f;
#pragma unroll
        for (int j = 0; j < 16; ++j) s += v[j];
        const float mean = wave_sum(s) * (1.f / SGW); float s2 = 0.f;
#pragma unroll
        for (int j = 0; j < 16; ++j) { const float d = v[j] - mean; s2 += d * d; }
        const float rstd = 1.f / sqrtf(wave_sum(s2) * (1.f / SGW) + LN_EPS);
        if (lane == 0) { st[2 * m] = mean; st[2 * m + 1] = rstd; }
        rc[0] = rn[0]; rc[1] = rn[1]; m = mn;
    }
}
constexpr size_t HG_QT = 0, HG_KT = 64 * MiB, HG_KTT = 128 * MiB, HG_EM = 192 * MiB, HG_EE = 194 * MiB, HG_ER = 196 * MiB;
struct HgRaw { unsigned f[8], q[8]; };
__device__ __forceinline__ void hg_gate_load(const Args& A, int item, int lane, HgRaw& R) {
    const int kg = item & 7, tile = item >> 3, h = tile & 15, bc = tile >> 4; const int tseg = lane >> 3, kp = lane & 7, ch = h * 128 + kg * 16 + 2 * kp;
    const unsigned* p = (const unsigned*)((const bf16*)(A.ws + WS_PROJ) + ((size_t)bc * 64 + tseg * 8) * PROJ + ch);
#pragma unroll
    for (int i = 0; i < 8; ++i) { R.f[i] = p[(size_t)i * (PROJ / 2) + C_F / 2]; R.q[i] = p[(size_t)i * (PROJ / 2) + C_Q / 2]; }
}
__device__ __forceinline__ void hg_gate_compute(const Args& A, unsigned char* hgs, int l, int item, int lane, const HgRaw& R) {
    const int kg = item & 7, tile = item >> 3, h = tile & 15, bc = tile >> 4;
    const int tseg = lane >> 3, kp = lane & 7, ch = h * 128 + kg * 16 + 2 * kp;
    bf16* QT = (bf16*)(hgs + HG_QT); bf16* KT = (bf16*)(hgs + HG_KT);
    float* EM = (float*)(hgs + HG_EM); float* EE = (float*)(hgs + HG_EE); float* ER = (float*)(hgs + HG_ER);
    float lb[2] = {0.f, 0.f};
    if (l == 1) { lb[0] = sigmoid_f(A.in[I_HGLB][HGW + ch] - A.in[I_HGLB][ch]); lb[1] = sigmoid_f(A.in[I_HGLB][HGW + ch + 1] - A.in[I_HGLB][ch + 1]); }
    float bcum[2][8], kv[2][8], qv[2][8];
    float run[2] = {0.f, 0.f};
#pragma unroll
    for (int i = 0; i < 8; ++i)
#pragma unroll
        for (int c = 0; c < 2; ++c) {
            const float fr = fmaxf(c ? bfhi(R.f[i]) : bflo(R.f[i]), -80.f), qr = c ? bfhi(R.q[i]) : bflo(R.q[i]); const float omlb = 1.0f - lb[c];
            const float e = __builtin_amdgcn_exp2f(-1.4426950408889634f * fr), den = 1.0f + e, f0 = __builtin_amdgcn_rcpf(den);
            float lf;
            if (l == 0) lf = -__builtin_amdgcn_logf(den); else lf = __builtin_amdgcn_logf(lb[c] + omlb * f0);
            run[c] += lf; bcum[c][i] = run[c]; kv[c][i] = omlb * e * f0; qv[c][i] = qr * __builtin_amdgcn_rcpf(1.0f + __builtin_amdgcn_exp2f(-1.4426950408889634f * qr));
        }
    float bmid[2], bend[2], off[2];
#pragma unroll
    for (int c = 0; c < 2; ++c) { float pre = 0.f, mid = 0.f, tot = 0.f;
#pragma unroll
        for (int j = 0; j < 8; ++j) { const float tj = __shfl(run[c], kp + 8 * j); if (j < tseg) pre += tj; if (j < 4) mid += tj; tot += tj; }
        off[c] = pre; bmid[c] = mid; bend[c] = tot; }
    const size_t ti0 = ((size_t)tile * 64 + tseg * 8) * 128 + kg * 16 + 2 * kp;
#pragma unroll
    for (int i = 0; i < 8; ++i) {
        const float d0 = (off[0] + bcum[0][i]) - bmid[0], d1 = (off[1] + bcum[1][i]) - bmid[1];
        const unsigned qp = pk2(qv[0][i] * __builtin_amdgcn_exp2f(d0), qv[1][i] * __builtin_amdgcn_exp2f(d1)), kp2 = pk2(kv[0][i] * __builtin_amdgcn_exp2f(-d0), kv[1][i] * __builtin_amdgcn_exp2f(-d1));
        *(unsigned*)(QT + ti0 + (size_t)i * 128) = qp; *(unsigned*)(KT + ti0 + (size_t)i * 128) = kp2;
    }
    if (tseg == 0) { typedef float f32x2g __attribute__((ext_vector_type(2)));
        *(f32x2g*)(EM + (size_t)bc * HGW + ch) = (f32x2g){__builtin_amdgcn_exp2f(bmid[0]), __builtin_amdgcn_exp2f(bmid[1])};
        *(f32x2g*)(EE + (size_t)bc * HGW + ch) = (f32x2g){__builtin_amdgcn_exp2f(bend[0]), __builtin_amdgcn_exp2f(bend[1])};
        *(f32x2g*)(ER + (size_t)bc * HGW + ch) = (f32x2g){__builtin_amdgcn_exp2f(bend[0] - bmid[0]), __builtin_amdgcn_exp2f(bend[1] - bmid[1])}; }
}
__device__ __forceinline__ void hg_gate_phase(const Args& A, unsigned char* hgs, int l, int gw, int NGW, int lane) {
    constexpr int NIT = BATCH * 64 * 16 * 8;
    HgRaw R0, R1;
    int it = gw; if (it >= NIT) return;
    hg_gate_load(A, it, lane, R0);
    for (;;) {
        const int it1 = it + NGW; if (it1 < NIT) hg_gate_load(A, it1, lane, R1);
        hg_gate_compute(A, hgs, l, it, lane, R0);
        if (it1 >= NIT) break;
        const int it2 = it1 + NGW; if (it2 < NIT) hg_gate_load(A, it2, lane, R0);
        hg_gate_compute(A, hgs, l, it1, lane, R1);
        if (it2 >= NIT) break;
        it = it2;
    }
}
constexpr int HGL_EL = 98304, HGL_PL = 102912, HGL_STL = 112128;
typedef short hg_s4v __attribute__((ext_vector_type(4)));
#define HG_TR(dst, addr, off) asm volatile("ds_read_b64_tr_b16 %0, %1 offset:%2" : "=v"(dst) : "v"(addr), "n"(off))
struct HgCtx { const char* qt; const char* kt; const char* vp; const char* em; bf16* o; int b, h, vq; unsigned gq[2], gv, ge; };
__device__ __forceinline__ void hg_dma(const HgCtx& X, LAS unsigned char* L, LAS unsigned char* LV, int c, int bi, int w, int lane) {
    const size_t tile = ((size_t)X.b * 64 + c) * 16 + X.h; const char* q = X.qt + tile * 16384; const char* k = X.kt + tile * 16384;
    LAS unsigned char* Qb = L + bi * 32768 + w * 2048;
#pragma unroll
    for (int i = 0; i < 2; ++i) { __builtin_amdgcn_global_load_lds((const unsigned*)(q + X.gq[i]), (LAS unsigned*)(Qb + i * 1024), 16, 0, 0);
                                  __builtin_amdgcn_global_load_lds((const unsigned*)(k + X.gq[i]), (LAS unsigned*)(Qb + 16384 + i * 1024), 16, 0, 0); }
    if (lane < 32) __builtin_amdgcn_global_load_lds((const unsigned*)(X.vp + (size_t)c * (64 * PROJ * 2) + X.gv), (LAS unsigned*)(LV + bi * 4096 + w * 512), 16, 0, 0);
    if (lane < 48) __builtin_amdgcn_global_load_lds((const unsigned*)(X.em + (size_t)c * (HGW * 4) + X.ge), (LAS unsigned*)(L + HGL_EL + bi * 1536 + w * 192), 4, 0, 0);
}
__device__ __forceinline__ void hg_step(const HgCtx& X, LAS unsigned char* L, LAS unsigned char* LV, int c, int bi, int bi2, f32x4 (&S)[2], int w, int lane, int l15, int l4, const unsigned (&swz)[4], const unsigned (&tro)[2], unsigned vo) {
    asm volatile("s_waitcnt vmcnt(6)" ::: "memory");
    LDS_BARRIER();
    hg_dma(X, L, LV, (c + 2 < 64) ? c + 2 : 63, bi2, w, lane);
    LAS unsigned char* Qb = L + bi * 32768; LAS unsigned char* Kb = Qb + 16384; LAS unsigned char* Vb = LV + bi * 4096; LAS float* EL = (LAS float*)(L + HGL_EL + bi * 1536);
    LAS bf16* PL = (LAS bf16*)(L + HGL_PL); LAS bf16* STL = (LAS bf16*)(L + HGL_STL);
    const int tt = w >> 1, st0 = 2 * (w & 1);
    bf16x8 qf[4], kf[2][4], ktf[2], vf[2][2];
#pragma unroll
    for (int kb = 0; kb < 4; ++kb) { qf[kb] = *(const LAS bf16x8*)(Qb + tt * 4096 + swz[kb]);
#pragma unroll
        for (int j = 0; j < 2; ++j) kf[j][kb] = *(const LAS bf16x8*)(Kb + (st0 + j) * 4096 + swz[kb]); }
    hg_s4v tk[2][2], tv[2][2][2];
    { const unsigned ka = (unsigned)(unsigned long long)Kb, va_ = (unsigned)(unsigned long long)Vb + vo; const unsigned k0 = ka + tro[0], k1 = ka + tro[1];
      HG_TR(tk[0][0], k0, 0); HG_TR(tk[0][1], k1, 0); HG_TR(tk[1][0], k0, 8192); HG_TR(tk[1][1], k1, 8192);
      HG_TR(tv[0][0][0], va_, 0); HG_TR(tv[0][0][1], va_, 256); HG_TR(tv[1][0][0], va_, 32); HG_TR(tv[1][0][1], va_, 288);
      HG_TR(tv[0][1][0], va_, 2048); HG_TR(tv[0][1][1], va_, 2304); HG_TR(tv[1][1][0], va_, 2080); HG_TR(tv[1][1][1], va_, 2336); }
    const f32x4 em = *(const LAS f32x4*)(EL + w * 16 + 4 * l4), ee = *(const LAS f32x4*)(EL + 128 + w * 16 + 4 * l4), er = *(const LAS f32x4*)(EL + 256 + w * 16 + 4 * l4);
    asm volatile("s_waitcnt lgkmcnt(0)" : "+v"(tk[0][0]), "+v"(tk[0][1]), "+v"(tk[1][0]), "+v"(tk[1][1]), "+v"(tv[0][0][0]), "+v"(tv[0][0][1]), "+v"(tv[1][0][0]), "+v"(tv[1][0][1]),
                 "+v"(tv[0][1][0]), "+v"(tv[0][1][1]), "+v"(tv[1][1][0]), "+v"(tv[1][1][1]) : : "memory"); __builtin_amdgcn_sched_barrier(0);
#pragma unroll
    for (int sb = 0; sb < 2; ++sb) { ktf[sb] = (bf16x8){tk[sb][0][0], tk[sb][0][1], tk[sb][0][2], tk[sb][0][3], tk[sb][1][0], tk[sb][1][1], tk[sb][1][2], tk[sb][1][3]};
#pragma unroll
        for (int vt = 0; vt < 2; ++vt) vf[vt][sb] = (bf16x8){tv[vt][sb][0][0], tv[vt][sb][0][1], tv[vt][sb][0][2], tv[vt][sb][0][3], tv[vt][sb][1][0], tv[vt][sb][1][1], tv[vt][sb][1][2], tv[vt][sb][1][3]}; }
    f32x4 pa[2], dS[2];
    pa[0] = (f32x4){0.f, 0.f, 0.f, 0.f}; pa[1] = pa[0]; dS[0] = pa[0]; dS[1] = pa[0];
#pragma unroll
    for (int kb = 0; kb < 4; ++kb) {
#pragma unroll
        for (int j = 0; j < 2; ++j) pa[j] = __builtin_amdgcn_mfma_f32_16x16x32_bf16(kf[j][kb], qf[kb], pa[j], 0, 0, 0);
        if (kb < 2) {
#pragma unroll
            for (int vt = 0; vt < 2; ++vt) dS[vt] = __builtin_amdgcn_mfma_f32_16x16x32_bf16(ktf[kb], vf[vt][kb], dS[vt], 0, 0, 0); }
    }
#pragma unroll
    for (int j = 0; j < 2; ++j) { const int st = st0 + j; f32x4 acc = pa[j];
        if (st > tt) acc = (f32x4){0.f, 0.f, 0.f, 0.f};
        if (st == tt) {
#pragma unroll
            for (int r = 0; r < 4; ++r) if (4 * l4 + r > l15) acc[r] = 0.f; }
        *(LAS unsigned long long*)(PL + (tt * 16 + l15) * 72 + st * 16 + 4 * l4) = (unsigned long long)pk2(acc[0], acc[1]) | ((unsigned long long)pk2(acc[2], acc[3]) << 32); }
#pragma unroll
    for (int vt = 0; vt < 2; ++vt) { const f32x4 sv = S[vt] * em;
        *(LAS unsigned long long*)(STL + (vt * 16 + l15) * 136 + w * 16 + 4 * l4) = (unsigned long long)pk2(sv[0], sv[1]) | ((unsigned long long)pk2(sv[2], sv[3]) << 32); }
    LDS_BARRIER();
    {   const int vt = w & 1;
        bf16x8 va[2], pb[2], sa[4];
#pragma unroll
        for (int sb = 0; sb < 2; ++sb) pb[sb] = *(const LAS bf16x8*)(PL + (tt * 16 + l15) * 72 + sb * 32 + 8 * l4);
        hg_s4v ta[2][2];
        { const unsigned va_ = (unsigned)(unsigned long long)Vb + vo + (unsigned)(vt * 32); HG_TR(ta[0][0], va_, 0); HG_TR(ta[0][1], va_, 256); HG_TR(ta[1][0], va_, 2048); HG_TR(ta[1][1], va_, 2304); }
#pragma unroll
        for (int kb = 0; kb < 4; ++kb) sa[kb] = *(const LAS bf16x8*)(STL + (vt * 16 + l15) * 136 + kb * 32 + 8 * l4);
        asm volatile("s_waitcnt lgkmcnt(0)" : "+v"(ta[0][0]), "+v"(ta[0][1]), "+v"(ta[1][0]), "+v"(ta[1][1]) : : "memory"); __builtin_amdgcn_sched_barrier(0);
#pragma unroll
        for (int sb = 0; sb < 2; ++sb) va[sb] = (bf16x8){ta[sb][0][0], ta[sb][0][1], ta[sb][0][2], ta[sb][0][3], ta[sb][1][0], ta[sb][1][1], ta[sb][1][2], ta[sb][1][3]};
        f32x4 a0 = (f32x4){0.f, 0.f, 0.f, 0.f}, a1 = a0;
#pragma unroll
        for (int sb = 0; sb < 2; ++sb) a0 = __builtin_amdgcn_mfma_f32_16x16x32_bf16(va[sb], pb[sb], a0, 0, 0, 0);
#pragma unroll
        for (int kb = 0; kb < 4; ++kb) { if (kb & 1) a0 = __builtin_amdgcn_mfma_f32_16x16x32_bf16(sa[kb], qf[kb], a0, 0, 0, 0); else a1 = __builtin_amdgcn_mfma_f32_16x16x32_bf16(sa[kb], qf[kb], a1, 0, 0, 0); }
        const f32x4 acc = a0 + a1;
        *(unsigned long long*)(X.o + (((size_t)X.b * 64 + c) * 64 + tt * 16 + l15) * HGW + X.h * 128 + X.vq * 32 + vt * 16 + 4 * l4) = (unsigned long long)pk2(acc[0], acc[1]) | ((unsigned long long)pk2(acc[2], acc[3]) << 32);
    }
#pragma unroll
    for (int vt = 0; vt < 2; ++vt) S[vt] = ee * S[vt] + er * dS[vt];
}
__device__ __forceinline__ void hg_chunk_item(const Args& A, Frame& F, const unsigned char* hgs, int item) {
    const int tid = tid_now(F), lane = tid & 63, w = F.wave, l15 = lane & 15, l4 = lane >> 4;
    LAS unsigned char* L = F.lds + RING_OFF; LAS unsigned char* LV = F.lds + STATL_OFF;
    HgCtx X; X.b = item >> 6; X.h = (item >> 2) & 15; X.vq = item & 3; X.o = (bf16*)(A.ws + WS_O);
    X.qt = (const char*)(hgs + HG_QT); X.kt = (const char*)(hgs + HG_KT);
    X.vp = (const char*)((const bf16*)(A.ws + WS_PROJ) + ((size_t)X.b * 64 * 64) * PROJ + C_I + X.h * 128 + X.vq * 32);
    X.em = (const char*)((const float*)(hgs + HG_EM) + ((size_t)X.b * 64) * HGW + X.h * 128);
#pragma unroll
    for (int i = 0; i < 2; ++i) { const int r = 4 * (2 * w + i) + (lane >> 4), cs = lane & 15; X.gq[i] = (unsigned)((r * 128 + ((cs ^ (r & 15)) * 8)) * 2); }
    X.gv = (unsigned)(((8 * w + (lane >> 2)) * PROJ + (lane & 3) * 8) * 2);
    { const int f = 48 * w + (lane < 48 ? lane : 0); X.ge = (unsigned)((f >> 7) * (2 * MiB) + (f & 127) * 4); }
    unsigned swz[4], tro[2];
#pragma unroll
    for (int kb = 0; kb < 4; ++kb) swz[kb] = (unsigned)(l15 * 256 + (((kb * 4 + l4) ^ l15) << 4));
#pragma unroll
    for (int hh = 0; hh < 2; ++hh) { const int sl = 8 * l4 + (l15 >> 2) + 4 * hh; tro[hh] = (unsigned)(sl * 256 + (((2 * w + ((l15 & 3) >> 1)) ^ (sl & 15)) << 4) + (l15 & 1) * 8); }
    const unsigned vo = (unsigned)((8 * l4 + (l15 >> 2)) * 64 + 8 * (l15 & 3));
    f32x4 S[2]; S[0] = (f32x4){0.f, 0.f, 0.f, 0.f}; S[1] = S[0];
    __syncthreads();
    hg_dma(X, L, LV, 0, 0, w, lane); hg_dma(X, L, LV, 1, 1, w, lane);
    int bi = 0, bi2 = 2;
#pragma unroll 1
    for (int c = 0; c < 64; ++c) { hg_step(X, L, LV, c, bi, bi2, S, w, lane, l15, l4, swz, tro, vo); bi = (bi == 2) ? 0 : bi + 1; bi2 = (bi2 == 2) ? 0 : bi2 + 1; }
    asm volatile("s_waitcnt vmcnt(0)" ::: "memory");
    __syncthreads();
}
constexpr size_t WS_S5M = WS_STAT + 1 * MiB, S5M_STRIDE = 262144, S5M_KM = 0, S5M_CI = 131072, S5M_BO = 196608;
constexpr size_t WS_XV = WS_S5M + 32 * MiB;
constexpr size_t WS_XH = WS_XV + 32 * MiB;
constexpr size_t WS_XL = WS_XH + 16 * MiB;
constexpr size_t WS_CVP = WS_XL + 16 * MiB;
constexpr size_t WS_MID = WS_CVP + 40 * MiB;
constexpr size_t WS_END2 = WS_MID + 344 * MiB;
static_assert(WS_CVP == WS_CVP_, "partial column-sum buffer offset");
__device__ __forceinline__ void s5_build_item(const Args& A, Frame& F, int item) {
    const int l = item >> 6, g = item & 63; const int tid = tid_now(F);
    LAS float* pw = (LAS float*)(F.lds + RING_OFF);
    LAS float* bb = pw + 17 * 64 * 2;
    LAS float* cc = bb + 64 * 16 * 2;
    LAS float* kt = cc + 16 * 64 * 2;
    if (tid < 64) { const int n = tid;
        const float lr = fminf(A.in[I_LAMRE][(l * 64 + g) * 64 + n], -1e-4f), li = A.in[I_LAMIM][(l * 64 + g) * 64 + n];
        const float dt = expf(A.in[I_LOGSTEP][l * 64 + g]);
        for (int t = 0; t <= 16; ++t) { const float mg = expf((float)t * lr * dt); float sn, cs; sincosf((float)t * li * dt, &sn, &cs); pw[(t * 64 + n) * 2] = mg * cs; pw[(t * 64 + n) * 2 + 1] = mg * sn; }
        const float mag = expf(lr * dt), ab_re = mag * cosf(li * dt), ab_im = mag * sinf(li * dt);
        const float den = lr * lr + li * li, nr = ab_re - 1.0f;
        const float g_re = (nr * lr + ab_im * li) / den, g_im = (ab_im * lr - nr * li) / den;
        for (int c = 0; c < 16; ++c) { const float br = A.in[I_BRE][((size_t)(l * 64 + g) * 64 + n) * 16 + c], bi = A.in[I_BIM][((size_t)(l * 64 + g) * 64 + n) * 16 + c];
            bb[(n * 16 + c) * 2] = g_re * br - g_im * bi; bb[(n * 16 + c) * 2 + 1] = g_re * bi + g_im * br;
            cc[(c * 64 + n) * 2] = A.in[I_CRE][((size_t)(l * 64 + g) * 16 + c) * 64 + n]; cc[(c * 64 + n) * 2 + 1] = A.in[I_CIM][((size_t)(l * 64 + g) * 16 + c) * 64 + n]; }
    }
    __syncthreads();
    for (int q = 0; q < 8; ++q) { const int idx = tid + 512 * q, t = idx >> 8, c = (idx >> 4) & 15, cp = idx & 15; float acc = 0.f;
        for (int n = 0; n < 64; ++n) { const float pr = pw[(t * 64 + n) * 2], pi = pw[(t * 64 + n) * 2 + 1], br = bb[(n * 16 + cp) * 2], bi = bb[(n * 16 + cp) * 2 + 1], cr = cc[(c * 64 + n) * 2], ci = cc[(c * 64 + n) * 2 + 1];
            const float wr = pr * br - pi * bi, wi = pr * bi + pi * br; acc += cr * wr - ci * wi; }
        kt[idx] = acc; }
    __syncthreads();
    unsigned char* base = A.ws + WS_S5M + (size_t)item * S5M_STRIDE;
    bf16* KM = (bf16*)(base + S5M_KM); bf16* CI = (bf16*)(base + S5M_CI); bf16* BO = (bf16*)(base + S5M_BO);
    for (int q = 0; q < 2; ++q) { const int v = tid + 512 * q, row = v >> 2, colv = v & 3, j = colv >> 1, c0 = (colv & 1) * 8, i = row >> 4, c = row & 15; float val[8];
#pragma unroll
        for (int e = 0; e < 8; ++e) { float x = (i >= j) ? kt[((i - j) * 16 + c) * 16 + c0 + e] : 0.f; if (i == j && c == c0 + e) x += A.in[I_S5D][l * S5W + g * 16 + c]; val[e] = x; }
        v4u o; o.x = pk2(val[0], val[1]); o.y = pk2(val[2], val[3]); o.z = pk2(val[4], val[5]); o.w = pk2(val[6], val[7]); *(v4u*)(KM + (size_t)row * 256 + colv * 8) = o; }
    for (int q = 0; q < 8; ++q) { const int v = tid + 512 * q, row = v >> 4, m0 = (v & 15) * 8, i = row >> 4, c = row & 15; float val[8];
#pragma unroll
        for (int e = 0; e < 8; ++e) { const int m = m0 + e, n = m & 63; const float pr = pw[((i + 1) * 64 + n) * 2], pi = pw[((i + 1) * 64 + n) * 2 + 1], cr = cc[(c * 64 + n) * 2], ci = cc[(c * 64 + n) * 2 + 1];
            val[e] = (m >= 64) ? -(cr * pi + ci * pr) : (cr * pr - ci * pi); }
        v4u o; o.x = pk2(val[0], val[1]); o.y = pk2(val[2], val[3]); o.z = pk2(val[4], val[5]); o.w = pk2(val[6], val[7]); *(v4u*)(CI + (size_t)row * 128 + m0) = o; }
    for (int q = 0; q < 8; ++q) { const int v = tid + 512 * q, m = v >> 5, colv = v & 31, j = colv >> 1, c0 = (colv & 1) * 8, n = m & 63; float val[8];
        const float pr = pw[((15 - j) * 64 + n) * 2], pi = pw[((15 - j) * 64 + n) * 2 + 1];
#pragma unroll
        for (int e = 0; e < 8; ++e) { const float br = bb[(n * 16 + c0 + e) * 2], bi = bb[(n * 16 + c0 + e) * 2 + 1]; val[e] = (m >= 64) ? (pr * bi + pi * br) : (pr * br - pi * bi); }
        v4u o; o.x = pk2(val[0], val[1]); o.y = pk2(val[2], val[3]); o.z = pk2(val[4], val[5]); o.w = pk2(val[6], val[7]); *(v4u*)(BO + (size_t)m * 256 + colv * 8) = o; }
    __syncthreads();
}
__device__ __forceinline__ const char* s5_ubase(const bf16* proj, int r0, int g, int kb) { const int b = r0 >> 8, ck = r0 & 255; return (const char*)(proj + ((size_t)b * SEQ + ck * 16 + 2 * kb) * PROJ + C_XA + g * 16); }
struct S5VFrag { bf16x8 u[2]; bf16x8 w[8]; };
__device__ __forceinline__ void s5_v_item(const Args& A, int l, int rb, int g, int lane) {
    const int l15 = lane & 15, l4 = lane >> 4;
    const bf16* proj = (const bf16*)(A.ws + WS_PROJ); const char* BO = (const char*)(A.ws + WS_S5M + (size_t)(l * 64 + g) * S5M_STRIDE + S5M_BO);
    float* XV = (float*)(A.ws + WS_XV);
    const unsigned uoff = (unsigned)((l15 * 16 + (l4 >> 1)) * PROJ * 2 + 16 * (l4 & 1)), boff = (unsigned)(l15 * 512 + l4 * 16);
    f32x4 acc[2][8];
#pragma unroll
    for (int mt = 0; mt < 2; ++mt)
#pragma unroll
        for (int nt = 0; nt < 8; ++nt) acc[mt][nt] = (f32x4){0.f, 0.f, 0.f, 0.f};
#define S5V_LOAD(F_, kb_) do { _Pragma("unroll") for (int mt = 0; mt < 2; ++mt) F_.u[mt] = *(const bf16x8*)(s5_ubase(proj, rb * 32 + mt * 16, g, (kb_)) + uoff); \
        _Pragma("unroll") for (int nt = 0; nt < 8; ++nt) F_.w[nt] = *(const bf16x8*)(BO + (nt * 16 * 512 + (kb_) * 64) + boff); } while (0)
#define S5V_MMA(F_) do { _Pragma("unroll") for (int nt = 0; nt < 8; ++nt) { _Pragma("unroll") for (int mt = 0; mt < 2; ++mt) acc[mt][nt] = __builtin_amdgcn_mfma_f32_16x16x32_bf16(F_.w[nt], F_.u[mt], acc[mt][nt], 0, 0, 0); } } while (0)
    S5VFrag F0, F1;
    S5V_LOAD(F0, 0);
#pragma unroll
    for (int kb = 0; kb < 8; kb += 2) { S5V_LOAD(F1, kb + 1); S5V_MMA(F0); if (kb + 2 < 8) S5V_LOAD(F0, kb + 2); S5V_MMA(F1); }
#undef S5V_LOAD
#undef S5V_MMA
    char* xvb = (char*)(XV + ((size_t)g * 1024 + rb * 32) * 128); const unsigned xoff = (unsigned)(l15 * 512 + l4 * 16);
#pragma unroll
    for (int mt = 0; mt < 2; ++mt)
#pragma unroll
        for (int nt = 0; nt < 8; ++nt) *(f32x4*)(xvb + (mt * 16 * 512 + nt * 64) + xoff) = acc[mt][nt];
}
__device__ __forceinline__ void s5_scan_wg(const Args& A, Frame& F, int l, int item, int lane) {
    const int g = item >> 2, b = item & 3, n = lane, w = F.wave;
    const float lr = fminf(A.in[I_LAMRE][(l * 64 + g) * 64 + n], -1e-4f), li = A.in[I_LAMIM][(l * 64 + g) * 64 + n];
    const float dt = expf(A.in[I_LOGSTEP][l * 64 + g]);
    const float mg = expf(16.f * lr * dt); float sn, cs; sincosf(16.f * li * dt, &sn, &cs);
    const float ar = mg * cs, ai = mg * sn;
    float br = ar, bi = ai;
#pragma unroll
    for (int q = 0; q < 5; ++q) { const float tr = br * br - bi * bi, ti = 2.f * br * bi; br = tr; bi = ti; }
    const float* XV = (const float*)(A.ws + WS_XV) + ((size_t)g * 1024 + b * 256 + 32 * w) * 128;
    bf16* XH = (bf16*)(A.ws + WS_XH) + ((size_t)g * 1024 + b * 256 + 32 * w) * 128; bf16* XL = (bf16*)(A.ws + WS_XL) + ((size_t)g * 1024 + b * 256 + 32 * w) * 128;
    LAS float* EX = (LAS float*)(F.lds + RING_OFF);
    float vr[32], vi[32];
#pragma unroll
    for (int k = 0; k < 32; ++k) { vr[k] = XV[k * 128 + n]; vi[k] = XV[k * 128 + 64 + n]; }
    float xr = 0.f, xi = 0.f;
#pragma unroll
    for (int k = 0; k < 32; ++k) { const float pr = xr, pi = xi; const float tr = ar * xr - ai * xi + vr[k], ti = ar * xi + ai * xr + vi[k]; xr = tr; xi = ti; vr[k] = pr; vi[k] = pi; }
    EX[(w * 64 + n) * 2] = xr; EX[(w * 64 + n) * 2 + 1] = xi;
    __syncthreads();
    float sr = 0.f, si = 0.f;
    for (int q = 0; q < w; ++q) { const float er = EX[(q * 64 + n) * 2], ei = EX[(q * 64 + n) * 2 + 1]; const float tr = br * sr - bi * si + er, ti = br * si + bi * sr + ei; sr = tr; si = ti; }
#pragma unroll
    for (int k = 0; k < 32; ++k) {
        const float pr = vr[k] + sr, pi = vi[k] + si;
        const unsigned hp = pk2(pr, pi); const float hr = __uint_as_float(hp << 16), hi = __uint_as_float(hp & 0xffff0000u); const unsigned lp = pk2(pr - hr, pi - hi);
        XH[k * 128 + n] = (bf16)(hp & 0xffffu); XH[k * 128 + 64 + n] = (bf16)(hp >> 16);
        XL[k * 128 + n] = (bf16)(lp & 0xffffu); XL[k * 128 + 64 + n] = (bf16)(lp >> 16);
        const float tr = ar * sr - ai * si, ti = ar * si + ai * sr; sr = tr; si = ti;
    }
    __syncthreads();
}
__device__ __forceinline__ void s5_y_item(const Args& A, int l, int rb, int g, int lane) {
    const int l15 = lane & 15, l4 = lane >> 4;
    const bf16* proj = (const bf16*)(A.ws + WS_PROJ);
    const char* KM = (const char*)(A.ws + WS_S5M + (size_t)(l * 64 + g) * S5M_STRIDE + S5M_KM); const char* CI = (const char*)(A.ws + WS_S5M + (size_t)(l * 64 + g) * S5M_STRIDE + S5M_CI);
    const char* XH = (const char*)(A.ws + WS_XH) + ((size_t)g * 1024 + rb * 32) * 256; const char* XL = (const char*)(A.ws + WS_XL) + ((size_t)g * 1024 + rb * 32) * 256;
    const unsigned uoff = (unsigned)((l15 * 16 + (l4 >> 1)) * PROJ * 2 + 16 * (l4 & 1)), koff = (unsigned)(l15 * 512 + l4 * 16), coff = (unsigned)(l15 * 256 + l4 * 16);
    bf16* Z = (bf16*)(A.ws + WS_Z);
#pragma unroll
    for (int hf = 0; hf < 2; ++hf) {
        f32x4 acc[2][8]; bf16x8 kmf[16];
#pragma unroll
        for (int mt = 0; mt < 2; ++mt)
#pragma unroll
            for (int n8 = 0; n8 < 8; ++n8) acc[mt][n8] = (f32x4){0.f, 0.f, 0.f, 0.f};
#pragma unroll
        for (int kb = 0; kb < 8; ++kb) if (2 * kb <= 8 * hf + 7) {
            bf16x8 u[2];
#pragma unroll
            for (int mt = 0; mt < 2; ++mt) u[mt] = *(const bf16x8*)(s5_ubase(proj, rb * 32 + mt * 16, g, kb) + uoff);
            if (kb == 0) {
#pragma unroll
                for (int d = 8 * hf; d < 8 * hf + 8; ++d) kmf[d] = *(const bf16x8*)(KM + (d * 16 * 512) + koff); }
            else {
#pragma unroll
                for (int e = 0; e < 2; ++e) { const int d = 8 * hf - 2 * kb + e; if (d >= 0) kmf[d] = *(const bf16x8*)(KM + (d * 16 * 512) + koff); } }
#pragma unroll
            for (int n8 = 0; n8 < 8; ++n8) { const int nt = 8 * hf + n8; if (2 * kb <= nt) {
#pragma unroll
                for (int mt = 0; mt < 2; ++mt) acc[mt][n8] = __builtin_amdgcn_mfma_f32_16x16x32_bf16(kmf[nt - 2 * kb], u[mt], acc[mt][n8], 0, 0, 0); } }
            asm volatile("" ::: "memory");
        }
#pragma unroll
        for (int kb = 0; kb < 4; ++kb) {
            bf16x8 xh[2], xl[2];
#pragma unroll
            for (int mt = 0; mt < 2; ++mt) { xh[mt] = *(const bf16x8*)(XH + (mt * 16 * 256 + kb * 64) + coff); xl[mt] = *(const bf16x8*)(XL + (mt * 16 * 256 + kb * 64) + coff); }
#pragma unroll
            for (int n8 = 0; n8 < 8; ++n8) { const int nt = 8 * hf + n8; const bf16x8 ci = *(const bf16x8*)(CI + (nt * 16 * 256 + kb * 64) + coff);
#pragma unroll
                for (int mt = 0; mt < 2; ++mt) { acc[mt][n8] = __builtin_amdgcn_mfma_f32_16x16x32_bf16(ci, xh[mt], acc[mt][n8], 0, 0, 0); acc[mt][n8] = __builtin_amdgcn_mfma_f32_16x16x32_bf16(ci, xl[mt], acc[mt][n8], 0, 0, 0); } }
            asm volatile("" ::: "memory");
        }
#pragma unroll
        for (int mt = 0; mt < 2; ++mt) { const int r0 = rb * 32 + mt * 16, b = r0 >> 8, ck = r0 & 255;
            char* zb = (char*)(Z + ((size_t)b * SEQ + ck * 16) * S5W + g * 16); const unsigned zoff = (unsigned)(l15 * 16 * S5W * 2 + l4 * 8);
#pragma unroll
            for (int n8 = 0; n8 < 8; ++n8) { const int nt = 8 * hf + n8; const f32x4 y = acc[mt][n8];
                *(unsigned long long*)(zb + nt * S5W * 2 + zoff) = (unsigned long long)pk2(gelu_f(y[0]), gelu_f(y[1])) | ((unsigned long long)pk2(gelu_f(y[2]), gelu_f(y[3])) << 32); } }
    }
}
__device__ __forceinline__ void sgu_phase(const Args& A, Frame& F, int l) {
    const int tid = tid_now(F), lane = tid & 63, w = F.wave, l15 = lane & 15, l4 = lane >> 4;
    const bf16* proj = (const bf16*)(A.ws + WS_PROJ); const float* st = (const float*)(A.ws + WS_STAT); bf16* uz = (bf16*)(A.ws + WS_UZ);
    LAS bf16* VNT = (LAS bf16*)(F.lds + RING_OFF); LAS bf16* WL = (LAS bf16*)(F.lds + RING_OFF + 34816); LAS float* SL = (LAS float*)(F.lds + RING_OFF + 69632);
    typedef float f32x2s __attribute__((ext_vector_type(2)));
    constexpr int NIT = (M / 128) * 8;
    const int dp = tid & 63, sseg = tid >> 6;
    unsigned rv[16]; f32x4 rw[8]; f32x2s rs = {0.f, 0.f}; unsigned long long ru[8]; float rb = 0.f; f32x2s lw = {0.f, 0.f}, lbias = {0.f, 0.f};
#define SGU_LOAD_A(it_) do { const int ch_ = (it_) >> 3, h_ = (it_) & 7; const size_t cs_ = (size_t)ch_ * 128; \
        const unsigned* pv_ = (const unsigned*)(proj + (cs_ + sseg * 16) * PROJ + C_V + h_ * 128 + 2 * dp); \
        _Pragma("unroll") for (int i = 0; i < 16; ++i) rv[i] = pv_[(size_t)i * (PROJ / 2)]; \
        const float* Wg_ = A.in[I_SGW] + ((size_t)(l * 8 + h_) * 128) * 128; \
        _Pragma("unroll") for (int q = 0; q < 4; ++q) { const int v_ = tid + 512 * q; rw[2 * q] = *(const f32x4*)(Wg_ + v_ * 8); rw[2 * q + 1] = *(const f32x4*)(Wg_ + v_ * 8 + 4); } \
        if (tid < 128) rs = *(const f32x2s*)(st + 2 * (cs_ + tid)); \
        lw = *(const f32x2s*)(A.in[I_SGLNW] + l * SGW + h_ * 128 + 2 * dp); lbias = *(const f32x2s*)(A.in[I_SGLNB] + l * SGW + h_ * 128 + 2 * dp); } while (0)
#define SGU_LOAD_B(it_) do { const int ch_ = (it_) >> 3, h_ = (it_) & 7; const size_t row_ = (size_t)ch_ * 128 + w * 16 + l15; \
        _Pragma("unroll") for (int dt = 0; dt < 8; ++dt) ru[dt] = *(const unsigned long long*)(proj + row_ * PROJ + C_U + h_ * 128 + dt * 16 + 4 * l4); \
        rb = A.in[I_SGB][(l * 8 + h_) * 128 + w * 16 + l15]; } while (0)
    int it = F.vcu; if (it >= NIT) return;
    SGU_LOAD_A(it); SGU_LOAD_B(it);
    for (;;) {
        const int nit = it + F.G; const int ch = it >> 3, h = it & 7;
        if (tid < 128) *(LAS f32x2s*)(SL + 2 * tid) = rs;
        LDS_BARRIER();
#pragma unroll
        for (int q = 0; q < 2; ++q) { float y0[8], y1[8];
#pragma unroll
            for (int e = 0; e < 8; ++e) { const int s = sseg * 16 + q * 8 + e; const f32x2s ms = *(const LAS f32x2s*)(SL + 2 * s); const unsigned wv = rv[q * 8 + e];
                y0[e] = (gelu_f(bflo(wv)) - ms[0]) * ms[1] * lw[0] + lbias[0]; y1[e] = (gelu_f(bfhi(wv)) - ms[0]) * ms[1] * lw[1] + lbias[1]; }
            v4u o; o.x = pk2(y0[0], y0[1]); o.y = pk2(y0[2], y0[3]); o.z = pk2(y0[4], y0[5]); o.w = pk2(y0[6], y0[7]); *(LAS v4u*)(VNT + (2 * dp) * 136 + sseg * 16 + q * 8) = o;
            v4u p; p.x = pk2(y1[0], y1[1]); p.y = pk2(y1[2], y1[3]); p.z = pk2(y1[4], y1[5]); p.w = pk2(y1[6], y1[7]); *(LAS v4u*)(VNT + (2 * dp + 1) * 136 + sseg * 16 + q * 8) = p; }
#pragma unroll
        for (int q = 0; q < 4; ++q) { const int v = tid + 512 * q, t = v >> 4, s0 = (v & 15) * 8; const f32x4 a = rw[2 * q], b = rw[2 * q + 1];
            v4u o; o.x = pk2(s0 + 0 <= t ? a[0] : 0.f, s0 + 1 <= t ? a[1] : 0.f); o.y = pk2(s0 + 2 <= t ? a[2] : 0.f, s0 + 3 <= t ? a[3] : 0.f);
            o.z = pk2(s0 + 4 <= t ? b[0] : 0.f, s0 + 5 <= t ? b[1] : 0.f); o.w = pk2(s0 + 6 <= t ? b[2] : 0.f, s0 + 7 <= t ? b[3] : 0.f);
            *(LAS v4u*)(WL + t * 136 + s0) = o; }
        if (nit < NIT) SGU_LOAD_A(nit);
        LDS_BARRIER();
        f32x4 acc[8];
#pragma unroll
        for (int dt = 0; dt < 8; ++dt) acc[dt] = (f32x4){0.f, 0.f, 0.f, 0.f};
        const int nkb = (w >> 1) + 1;
        for (int kb = 0; kb < nkb; ++kb) {
            const bf16x8 wb = *(const LAS bf16x8*)(WL + (w * 16 + l15) * 136 + kb * 32 + 8 * l4);
#pragma unroll
            for (int dt = 0; dt < 8; ++dt) { const bf16x8 va = *(const LAS bf16x8*)(VNT + (dt * 16 + l15) * 136 + kb * 32 + 8 * l4);
                acc[dt] = __builtin_amdgcn_mfma_f32_16x16x32_bf16(va, wb, acc[dt], 0, 0, 0); }
        }
        {   const size_t row = (size_t)ch * 128 + w * 16 + l15;
#pragma unroll
            for (int dt = 0; dt < 8; ++dt) { const unsigned long long uw = ru[dt];
                const float o0 = gelu_f(bflo((unsigned)uw)) * (acc[dt][0] + rb), o1 = gelu_f(bfhi((unsigned)uw)) * (acc[dt][1] + rb), o2 = gelu_f(bflo((unsigned)(uw >> 32))) * (acc[dt][2] + rb), o3 = gelu_f(bfhi((unsigned)(uw >> 32))) * (acc[dt][3] + rb);
                *(unsigned long long*)(uz + row * SGW + h * 128 + dt * 16 + 4 * l4) = (unsigned long long)pk2(o0, o1) | ((unsigned long long)pk2(o2, o3) << 32); }
        }
        if (nit >= NIT) break;
        SGU_LOAD_B(nit);
        it = nit;
    }
    __syncthreads();
#undef SGU_LOAD_A
#undef SGU_LOAD_B
}
constexpr int PH_PER_LAYER = 10, N_PHASES = 2 + DEPTH * PH_PER_LAYER;
#ifndef PROBE_REP
#define PROBE_REP 0
#endif
#define REPC(c) _Pragma("unroll 1") for (int rep_ = 0, rep_n_ = (((PROBE_REP >> (c)) & 1) ? ((int)(args.rep >> (4 * (c))) & 15) : 1); rep_ < rep_n_; ++rep_)
#ifndef MK_ONE_LAUNCH
#define MK_ONE_LAUNCH 1
#endif
__global__ void __launch_bounds__(NWAVES * 64, 2) mega_fwd(KArgs kargs) {
    extern __shared__ __attribute__((aligned(16))) unsigned char lds[];
    Frame F;
    F.lds = (LAS unsigned char*)lds;
    F.wave = __builtin_amdgcn_readfirstlane((int)threadIdx.x >> 6);
    F.G = gridDim.x; { const int bx = blockIdx.x; F.vcu = (F.G % 8 == 0) ? (bx % 8) * (F.G / 8) + bx / 8 : bx; }
    Args args; args.in.t = (LAS const unsigned*)(F.lds + ARGTAB_OFF); args.out = kargs.out; args.ws = kargs.ws; args.rep = kargs.rep; args.ph_lo = kargs.ph_lo; args.ph_hi = kargs.ph_hi;
    unsigned char* ws = args.ws;
    unsigned* ctl = (unsigned*)(ws + WS_CTL);
    for (int u = (int)threadIdx.x; u < (LDS_BYTES - LDSCTL_OFF) / 4; u += NWAVES * 64) ((LAS unsigned*)(F.lds + LDSCTL_OFF))[u] = 0u;
    __syncthreads();
    if (threadIdx.x == 0) {
#pragma unroll
        for (int i = 0; i < N_IN; ++i) { const unsigned long long p_ = (unsigned long long)kargs.in[i]; ((LAS unsigned*)(F.lds + ARGTAB_OFF))[2 * i] = (unsigned)p_; ((LAS unsigned*)(F.lds + ARGTAB_OFF))[2 * i + 1] = (unsigned)(p_ >> 32); } }
    __syncthreads();
#if MK_ONE_LAUNCH
    XcdBarrier bar = xcd_barrier_post(ctl + CW_BAR, (volatile LAS unsigned*)(F.lds + MISC_OFF) + 8);
    if (threadIdx.x == 0) { const unsigned g_ = blockIdx.x & 7u, id_ = xb_xcc_id(); atomicMax(ctl + CW_GRP + 64 * g_, id_ + 1u); atomicMax(ctl + CW_GRP + 512 + 64 * g_, 16u - id_); xb_add(ctl + CW_GRP + 1024 + 64 * g_, 1u); }
    int grp_ok = 0;
#define LSEAM(k) do { if (grp_ok) { SPAN_B(100); grp_barrier(ctl + CW_TEAM + 64 * (blockIdx.x & 63u), 4u, ctl + CW_BAR); SPAN_E(100); } else SEAM(k); } while (0)
#define SEAM(k) do { if (IN(k) && IN((k) + 1)) { SPAN_B(100); SPAN_B(101 + ((k) == 0 ? 13 : ((k) - 1) % PH_PER_LAYER)); xcd_barrier(bar); SPAN_E(100); SPAN_E(101 + ((k) == 0 ? 13 : ((k) - 1) % PH_PER_LAYER)); } } while (0)
#else
#define SEAM(k) do { } while (0)
#endif
    unsigned long long pr_t0 = 0; F.pr_acc = 0; F.pr_me = (blockIdx.x == 0 && F.wave == 0);
#define SPAN_B(id) do { if (PROBE_SPAN == (id) && F.pr_me) pr_t0 = __builtin_amdgcn_s_memrealtime(); } while (0)
#define SPAN_E(id) do { if (PROBE_SPAN == (id) && F.pr_me) F.pr_acc += __builtin_amdgcn_s_memrealtime() - pr_t0; } while (0)
    const int lo = args.ph_lo, hi = args.ph_hi;
#if MK_ONE_LAUNCH
#define IN(k) true
#else
#define IN(k) (lo <= (k) && (k) < hi)
#endif
    const int gw = F.vcu * NWAVES + F.wave, NGW = F.G * NWAVES;

    SPAN_B(50); if (IN(0)) REPC(0) { p0_prologue(args, F); __syncthreads(); for (int it = F.vcu; it < DEPTH * 64; it += F.G) s5_build_item(args, F, it); }
    SPAN_E(50); SEAM(0);
#if MK_ONE_LAUNCH
    { unsigned ok_ = (gridDim.x == 256u) ? 1u : 0u;
      for (int g_ = 0; g_ < 8; ++g_) { const unsigned a_ = xb_ld(ctl + CW_GRP + 64 * g_), b_ = xb_ld(ctl + CW_GRP + 512 + 64 * g_), c_ = xb_ld(ctl + CW_GRP + 1024 + 64 * g_); if (a_ + b_ != 17u || c_ != 32u) ok_ = 0u; }
      grp_ok = __builtin_amdgcn_readfirstlane((int)ok_); }
#endif
#pragma unroll 1
    for (int l = 0; l < DEPTH; ++l) {
        const int pb = 1 + l * PH_PER_LAYER;
        { unsigned long long wsp_ = (unsigned long long)ws; asm volatile("" : "+s"(wsp_)); ws = (unsigned char*)wsp_; }
        const unsigned char* wl = ws + WS_W + (size_t)l * WL_STRIDE;
        bf16* hb = (bf16*)(ws + WS_HB); const float* cvec = (const float*)(ws + WS_CTL + CTL_CVEC) + (size_t)l * 2 * CV_N;
#define STATS(k) ((float*)(ws + WS_CTL + CTL_STATS + (size_t)(k) * STATS_BYTES))
#define STATL ((const float*)(unsigned long long)(unsigned)(unsigned long long)(F.lds + STATL_OFF))
#define TB(n) ((bf16*)(ws + (((n) & 1) ? WS_HF : WS_T)))
        SPAN_B(1); if (IN(pb + 0)) REPC(1) { pg8::StaticOrder S; S.init(M, PROJ, F.G, bid_now());
            if (l == 0) { pg8::Gemm g{hb, (const bf16*)(wl + WO_IN), M, PROJ, D}; pg8::EpiBf16Plain E{(bf16*)(ws + WS_PROJ), PROJ}; pg8::gemm_phase<pg8::EpiBf16Plain, pg8::StaticOrder, true, true>(F.lds + RING_OFF, g, S, E); }
            else { stats_to_lds(F, STATS(3 * l - 1)); pg8::Gemm g{TB(3 * l - 1), (const bf16*)(wl + WO_IN), M, PROJ, D}; pg8::EpiLnBf16 E{(bf16*)(ws + WS_PROJ), PROJ, STATL, cvec + CV_IN, cvec + CV_N + CV_IN}; pg8::gemm_phase<pg8::EpiLnBf16, pg8::StaticOrder, true, true>(F.lds + RING_OFF, g, S, E); } }
        SPAN_E(1); SEAM(pb + 0);
        SPAN_B(2); if (IN(pb + 1)) REPC(3) {
            const int lane = lane_now();
            SPAN_B(21); REPC(7) for (int it = gw; it < 32 * 64; it += NGW) s5_v_item(args, l, it >> 6, ((it >> 3) & 7) * 8 + (it & 7), lane);
            SPAN_E(21); SPAN_B(22); REPC(8) sgu_stats_phase(args, gw, NGW, lane);
            if (l == 0) cvec_reduce(args, gw, NGW, lane);
            SPAN_E(22); SPAN_B(23); REPC(9) hg_gate_phase(args, (unsigned char*)TB(3 * l), l, gw, NGW, lane); SPAN_E(23);
        }
        SPAN_E(2); SEAM(pb + 1);
        SPAN_B(3); if (IN(pb + 2)) REPC(5) {
            { const int lane = lane_now(); for (int it = F.vcu; it < 64 * BATCH; it += F.G) s5_scan_wg(args, F, l, it, lane); }
            for (int it = F.vcu; it < BATCH * 16 * 4; it += F.G) hg_chunk_item(args, F, (const unsigned char*)TB(3 * l), it);
        }
        SPAN_E(3); SEAM(pb + 2);
        SPAN_B(4); if (IN(pb + 3)) REPC(6) {
            { const int lane = lane_now(); REPC(10) for (int it = gw; it < 32 * 64; it += NGW) s5_y_item(args, l, it >> 6, ((it >> 3) & 7) * 8 + (it & 7), lane); }
            __syncthreads();
            sgu_phase(args, F, l);
        }
        SPAN_E(4); SEAM(pb + 3);
        SPAN_B(5); if (IN(pb + 4)) REPC(1) { pg8::Gemm g{(const bf16*)(ws + WS_Z), (const bf16*)(wl + WO_GLU), M, S5W, S5W}; pg8::StaticOrder S; S.init(M, S5W, F.G, bid_now());
            pg8::EpiGlu E{(const bf16*)(ws + WS_Z), (bf16*)(ws + WS_ZA), S5W}; pg8::gemm_phase<pg8::EpiGlu, pg8::StaticOrder, true, true>(F.lds + RING_OFF, g, S, E); }
        SPAN_E(5); LSEAM(pb + 4);
        SPAN_B(6); if (IN(pb + 5)) REPC(4) norm_phase(args, F, l);
        SPAN_E(6); LSEAM(pb + 5);
        SPAN_B(7); if (IN(pb + 6)) REPC(1) { pg8::Gemm g{(const bf16*)(ws + WS_CAT), (const bf16*)(wl + WO_OUT), M, D, D}; pg8::StaticOrder S; S.init(M, D, F.G, bid_now());
            if (l == 0) { pg8::EpiRes<true> E{args.in[I_X], (const bf16*)nullptr, (const float*)nullptr, (const float*)nullptr, (const float*)nullptr, TB(0), STATS(0), D, ALPHA}; pg8::gemm_phase<pg8::EpiRes<true>, pg8::StaticOrder, true, true>(F.lds + RING_OFF, g, S, E); }
            else { stats_to_lds(F, STATS(3 * l - 1)); pg8::EpiRes<false> E{(const float*)nullptr, TB(3 * l - 1), STATL, args.in[I_LN3W] + (l - 1) * D, args.in[I_LN3B] + (l - 1) * D, TB(3 * l), STATS(3 * l), D, ALPHA}; pg8::gemm_phase<pg8::EpiRes<false>, pg8::StaticOrder, true, true>(F.lds + RING_OFF, g, S, E); } }
        SPAN_E(7); LSEAM(pb + 6);
        SPAN_B(9); if (IN(pb + 7)) REPC(1) { stats_to_lds(F, STATS(3 * l)); { pg8::Gemm g{TB(3 * l), (const bf16*)(wl + WO_FI), M, 2 * DFF, D}; pg8::StaticOrder S; S.init(M, 2 * DFF, F.G, bid_now());
              pg8::EpiSwiGLU E{(bf16*)(ws + WS_MID), DFF, STATL, cvec + CV_FI, cvec + CV_N + CV_FI}; pg8::gemm_phase<pg8::EpiSwiGLU, pg8::StaticOrder, true, true>(F.lds + RING_OFF, g, S, E); }
            int Gq = F.G; asm volatile("" : "+s"(Gq));
            const int nfull = ((M / 256) * (2 * DFF / 256)) % Gq;
            const int nshort = Gq - nfull, cs = bid_now() - nfull;
            if (cs >= 0) { int kple = PLE; asm volatile("" : "+s"(kple));
              pg8::Gemm g{(const bf16*)(ws + WS_PB) + (size_t)l * M * PLE, (const bf16*)(wl + WO_PI), M, D, kple}; pg8::StaticOrder S; S.init(M, D, nshort, cs);
              pg8::EpiBf16Plain E{(bf16*)(ws + WS_CAT), D}; pg8::gemm_phase<pg8::EpiBf16Plain, pg8::StaticOrder, true, true>(F.lds + RING_OFF, g, S, E); } }
        SPAN_E(9); LSEAM(pb + 7);
        SPAN_B(10); if (IN(pb + 8)) REPC(1) { stats_to_lds(F, STATS(3 * l)); pg8::Gemm g{(const bf16*)(ws + WS_MID), (const bf16*)(wl + WO_FO), M, D, DFF}; pg8::StaticOrder S; S.init(M, D, F.G, bid_now());
            pg8::EpiRes<false> E{(const float*)nullptr, TB(3 * l), STATL, args.in[I_LN1W] + l * D, args.in[I_LN1B] + l * D, TB(3 * l + 1), STATS(3 * l + 1), D, ALPHA}; pg8::gemm_phase<pg8::EpiRes<false>, pg8::StaticOrder, true, true>(F.lds + RING_OFF, g, S, E); }
        SPAN_E(10); LSEAM(pb + 8);
        SPAN_B(12); if (IN(pb + 9)) REPC(1) { stats_to_lds(F, STATS(3 * l + 1)); pg8::Gemm g{TB(3 * l + 1), (const bf16*)(wl + WO_PG), M, D, D}; pg8::StaticOrder S; S.init(M, D, F.G, bid_now());
            pg8::EpiPle E{TB(3 * l + 1), STATL, args.in[I_LN2W] + l * D, args.in[I_LN2B] + l * D, cvec + CV_PG, cvec + CV_N + CV_PG, (const bf16*)(ws + WS_CAT), TB(3 * l + 2), STATS(3 * l + 2), D, ALPHA};
            pg8::gemm_phase<pg8::EpiPle, pg8::StaticOrder, true, true>(F.lds + RING_OFF, g, S, E); }
        SPAN_E(12);
        if (PROBE_SPAN != 0 && l == DEPTH - 1 && F.pr_me) { const unsigned long long t0_ = __builtin_amdgcn_s_memrealtime(); while (__builtin_amdgcn_s_memrealtime() - t0_ < 8ull * F.pr_acc) __builtin_amdgcn_s_sleep(8); }
        if (l == DEPTH - 1) SEAM(pb + 9); else LSEAM(pb + 9);
    }
    { const int pl = 1 + DEPTH * PH_PER_LAYER; SPAN_B(13); if (IN(pl)) REPC(2) ln_phase(F, (const bf16*)(ws + (((3 * DEPTH - 1) & 1) ? WS_HF : WS_T)), args.in[I_LN3W] + (DEPTH - 1) * D, args.in[I_LN3B] + (DEPTH - 1) * D, args.out, (bf16*)nullptr, (float*)nullptr); SPAN_E(13); }
#undef IN
#undef SEAM
#undef TB
#undef STATS
#undef STATL
    (void)gw; (void)NGW; (void)ctl; (void)lo; (void)hi;
}

extern "C" void kernel_launch(void* const* d_in, const int* in_sizes, int n_in, void* d_out, int out_size, void* d_ws, size_t ws_size, hipStream_t stream) {
    static int grid = 0;
    if (grid == 0) {
        if (n_in != N_IN || in_sizes[0] != M * D || out_size != M * D || ws_size < WS_END2) { fprintf(stderr, "kernel_launch: unexpected shapes: n_in %d in0 %d out %d ws %zu (need %zu)\n", n_in, n_in > 0 ? in_sizes[0] : -1, out_size, ws_size, (size_t)WS_END2); grid = -1; return; }
        int dev = 0, cus = 0, per_cu = 0;
        if (hipGetDevice(&dev) != hipSuccess || hipDeviceGetAttribute(&cus, hipDeviceAttributeMultiprocessorCount, dev) != hipSuccess) { grid = -1; return; }
        if (hipFuncSetAttribute((const void*)mega_fwd, hipFuncAttributeMaxDynamicSharedMemorySize, LDS_BYTES) != hipSuccess) { fprintf(stderr, "kernel_launch: hipFuncSetAttribute failed\n"); grid = -1; return; }
        if (hipOccupancyMaxActiveBlocksPerMultiprocessor(&per_cu, (const void*)mega_fwd, NWAVES * 64, LDS_BYTES) != hipSuccess || per_cu < 1) fprintf(stderr, "kernel_launch: occupancy query says %d\n", per_cu);
        (void)hipGetLastError();
        grid = cus;
    }
    if (grid < 0) return;
    (void)hipMemsetAsync((char*)d_ws + WS_CTL, 0, CTL_ZERO_BYTES, stream);
    KArgs a{};
    for (int i = 0; i < N_IN; ++i) a.in[i] = (const float*)d_in[i];
    a.out = (float*)d_out; a.ws = (unsigned char*)d_ws; a.rep = 0x111111111111ull; for (int c = 0; c < 12; ++c) if ((PROBE_REP >> c) & 1) a.rep += 1ull << (4 * c);
#if MK_ONE_LAUNCH
    a.ph_lo = 0; a.ph_hi = N_PHASES;
    hipLaunchKernelGGL(mega_fwd, dim3(grid), dim3(NWAVES * 64), LDS_BYTES, stream, a);
#else
    for (int p = 0; p < N_PHASES; ++p) { a.ph_lo = p; a.ph_hi = p + 1; hipLaunchKernelGGL(mega_fwd, dim3(grid), dim3(NWAVES * 64), LDS_BYTES, stream, a); }
#endif
}
```

```cpp
#include <hip/hip_runtime.h>
#include <cstdio>
#include <cstdint>
namespace pg8 {
#define PG8_LAS __attribute__((address_space(3)))
typedef unsigned short bf16_t;
typedef short bf16x8 __attribute__((ext_vector_type(8)));
typedef float f32x4 __attribute__((ext_vector_type(4)));
typedef unsigned u32x4 __attribute__((ext_vector_type(4)));
constexpr int BM = 256, BK = 64, HALF = 128, HTB = HALF * BK * 2  , STAGE_BYTES = 8 * HTB, NXCD = 8, WGM = 8;

__host__ __device__ __forceinline__ int lds_byte(int r, int c) { const int st = (r >> 4) * 2 + (c >> 5), rr = r & 15, cc = c & 31, ob = rr * 64 + cc * 2; return st * 1024 + (ob ^ (((ob >> 9) & 1) << 5)); }
__host__ __device__ __forceinline__ void stage_rc(int b, int& R, int& C) { const int st = b / 1024, sb = b % 1024, swz = sb ^ (((sb >> 9) & 1) << 5); R = (st >> 1) * 16 + swz / 64; C = (st & 1) * 32 + (swz % 64) / 2; }
__host__ __device__ __forceinline__ int perm32(int rho) { const int n = rho >> 4, i = rho & 15; return 8 * (i >> 2) + 4 * n + (i & 3); }

struct Unit { int pm, pn; };
struct Gemm { const bf16_t* A; const bf16_t* Bt; int M, N, K; };

struct StaticOrder {
    int nM, nN, nwg, G, c;
    __host__ __device__ void init(int M, int N, int G_, int c_) { nM = M / BM; nN = N / BM; nwg = nM * nN; G = G_; c = c_; }
    __host__ __device__ bool next(int i, Unit& u) const {
        const long L = (long)i * G + c; if (L >= nwg) return false;
        int wgid = (int)L; { const int q = nwg / NXCD, r = nwg % NXCD, xcd = wgid % NXCD, off = wgid / NXCD; wgid = (xcd < r ? xcd * (q + 1) : r * (q + 1) + (xcd - r) * q) + off; }
        const int nig = WGM * nN, gid = wgid / nig, fm = gid * WGM, gsz = (nM - fm) < WGM ? (nM - fm) : WGM;
        u.pm = fm + ((wgid % nig) % gsz); u.pn = (wgid % nig) / gsz; return true;
    }
    __device__ __forceinline__ void a_ready(const Unit&) const {}
    __device__ __forceinline__ void done(const Unit&) const {}
};
struct PiOrder {
    int first, count, n_units;
    __host__ __device__ bool next(int i, Unit& u) const { if (i >= count) return false; const int idx = first + i; u.pm = idx >> 4; u.pn = idx & 15; return true; }
    __device__ __forceinline__ void a_ready(const Unit&) const {}
    __device__ __forceinline__ void done(const Unit&) const {}
};
typedef float f32x2 __attribute__((ext_vector_type(2)));
typedef __bf16 bf16x2v __attribute__((ext_vector_type(2)));
__device__ __forceinline__ unsigned cvt_pk_bf16(float lo, float hi) { const f32x2 v = {lo, hi}; return __builtin_bit_cast(unsigned, __builtin_convertvector(v, bf16x2v)); }
__device__ __forceinline__ float sigm(float x) { return __builtin_amdgcn_rcpf(1.0f + __builtin_amdgcn_exp2f(-1.4426950408889634f * x)); }
__device__ __forceinline__ void row_stats(const float* st, int row, float& mean, float& rstd) {
    typedef float f32x2l __attribute__((ext_vector_type(2))); const f32x2l v = *(const PG8_LAS f32x2l*)((PG8_LAS const char*)(unsigned)(unsigned long long)st + (row & 2047) * 8); mean = v[0]; rstd = v[1]; }
__device__ __forceinline__ f32x2 bf2(unsigned w) { return (f32x2){__uint_as_float(w << 16), __uint_as_float(w & 0xffff0000u)}; }
__device__ __forceinline__ f32x2 sp2(float s) { return (f32x2){s, s}; }
__device__ __forceinline__ f32x2 lo2(const f32x4 v) { return (f32x2){v[0], v[1]}; }
__device__ __forceinline__ f32x2 hi2(const f32x4 v) { return (f32x2){v[2], v[3]}; }
__device__ __forceinline__ f32x2 fma2(f32x2 a, f32x2 b, f32x2 c) { return __builtin_elementwise_fma(a, b, c); }
__device__ __forceinline__ void stat_add(float* p, float v) { __hip_atomic_fetch_add(p, v, __ATOMIC_RELAXED, __HIP_MEMORY_SCOPE_AGENT); }
constexpr int SGV_PN0 = 8;
__device__ __forceinline__ float gelu_e(float x) { const float x2 = x * x; const float a2 = x * (-2.302208198f - 0.102943240f * x2); return x * __builtin_amdgcn_rcpf(1.0f + __builtin_amdgcn_exp2f(a2)); }
__device__ __forceinline__ void sg_acc(const u32x4 w, float& s, float& q) {
#pragma unroll
    for (int e = 0; e < 4; ++e) { const float a = gelu_e(__uint_as_float(w[e] << 16)), b = gelu_e(__uint_as_float(w[e] & 0xffff0000u)); s += a + b; q = fmaf(a, a, fmaf(b, b, q)); }
}
__device__ __forceinline__ void sg_flush(float* sg, int row, int fq, float s, float q) {
    s += __shfl_xor(s, 16); s += __shfl_xor(s, 32); q += __shfl_xor(q, 16); q += __shfl_xor(q, 32);
    if (fq == 0) { stat_add(sg + 2 * row, s); stat_add(sg + 2 * row + 1, q); }
}
struct EpiBf16Plain {
    static constexpr bool PERM = true, AFTER_DRAIN = false;
    bf16_t* O; int ldc; float* sg;
    __device__ __forceinline__ void operator()(const f32x4 (&acc)[2][2][4][2], const Unit& u, int wr, int wc, int fr, int fq) const {
        const int row0 = u.pm * BM + wr * 64 + fr, col0 = u.pn * BM + wc * 32 + 8 * fq;
        const bool sgu = sg != nullptr && u.pn >= SGV_PN0 && u.pn < SGV_PN0 + 4;
#pragma unroll
        for (int ai = 0; ai < 2; ++ai)
#pragma unroll
            for (int m = 0; m < 4; ++m) { bf16_t* rowp = O + (size_t)(row0 + ai * HALF + m * 16) * ldc + col0; float s_ = 0.f, q_ = 0.f;
#pragma unroll
                for (int bj = 0; bj < 2; ++bj) { const f32x4 v0 = acc[ai][bj][m][0], v1 = acc[ai][bj][m][1];
                    u32x4 w; w.x = cvt_pk_bf16(v0[0], v0[1]); w.y = cvt_pk_bf16(v0[2], v0[3]); w.z = cvt_pk_bf16(v1[0], v1[1]); w.w = cvt_pk_bf16(v1[2], v1[3]);
                    *(u32x4*)(rowp + bj * HALF) = w; if (sgu) sg_acc(w, s_, q_); }
                if (sgu) sg_flush(sg, row0 + ai * HALF + m * 16, fq, s_, q_); }
    }
};
struct EpiLnBf16 {
    static constexpr bool PERM = true, AFTER_DRAIN = false;
    bf16_t* O; int ldc; const float* st; const float* c1; const float* c2; float* sg;
    __device__ __forceinline__ void operator()(const f32x4 (&acc)[2][2][4][2], const Unit& u, int wr, int wc, int fr, int fq) const {
        const int row0 = u.pm * BM + wr * 64 + fr, col0 = u.pn * BM + wc * 32 + 8 * fq;
        const bool sgu = sg != nullptr && u.pn >= SGV_PN0 && u.pn < SGV_PN0 + 4;
        f32x4 a1[2][2], a2[2][2];
#pragma unroll
        for (int bj = 0; bj < 2; ++bj)
#pragma unroll
            for (int n = 0; n < 2; ++n) { a1[bj][n] = *(const f32x4*)(c1 + col0 + bj * HALF + 4 * n); a2[bj][n] = *(const f32x4*)(c2 + col0 + bj * HALF + 4 * n); }
#pragma unroll
        for (int ai = 0; ai < 2; ++ai)
#pragma unroll
            for (int m = 0; m < 4; ++m) { const int row = row0 + ai * HALF + m * 16; bf16_t* rowp = O + (size_t)row * ldc + col0;
                float mn_, rs; row_stats(st, row, mn_, rs); const float rm = rs * mn_; float s_ = 0.f, q_ = 0.f;
#pragma unroll
                for (int bj = 0; bj < 2; ++bj) { const f32x4 v0 = acc[ai][bj][m][0] * rs - a1[bj][0] * rm + a2[bj][0], v1 = acc[ai][bj][m][1] * rs - a1[bj][1] * rm + a2[bj][1];
                    u32x4 w; w.x = cvt_pk_bf16(v0[0], v0[1]); w.y = cvt_pk_bf16(v0[2], v0[3]); w.z = cvt_pk_bf16(v1[0], v1[1]); w.w = cvt_pk_bf16(v1[2], v1[3]);
                    *(u32x4*)(rowp + bj * HALF) = w; if (sgu) sg_acc(w, s_, q_); }
                if (sgu) sg_flush(sg, row, fq, s_, q_); }
    }
};
struct EpiSwiGLU {
    static constexpr bool PERM = true, AFTER_DRAIN = false;
    bf16_t* O; int ldc; const float* st; const float* c1; const float* c2;
    __device__ __forceinline__ void operator()(const f32x4 (&acc)[2][2][4][2], const Unit& u, int wr, int wc, int fr, int fq) const {
        const int row0 = u.pm * BM + wr * 64 + fr, col0 = u.pn * HALF + wc * 32 + 8 * fq, ccol = u.pn * BM + wc * 32 + 8 * fq;
        f32x2 a1[2][4], a2[2][4];
#pragma unroll
        for (int bj = 0; bj < 2; ++bj)
#pragma unroll
            for (int n = 0; n < 2; ++n) { const f32x4 x1 = *(const f32x4*)(c1 + ccol + bj * HALF + 4 * n), x2 = *(const f32x4*)(c2 + ccol + bj * HALF + 4 * n);
                a1[bj][2 * n] = lo2(x1); a1[bj][2 * n + 1] = hi2(x1); a2[bj][2 * n] = lo2(x2); a2[bj][2 * n + 1] = hi2(x2); }
#pragma unroll
        for (int ai = 0; ai < 2; ++ai)
#pragma unroll
            for (int m = 0; m < 4; ++m) { const int row = row0 + ai * HALF + m * 16; bf16_t* rowp = O + (size_t)row * ldc + col0;
                float mn_, rs; row_stats(st, row, mn_, rs); const f32x2 rs2 = sp2(rs), nrm2 = sp2(-rs * mn_);
                u32x4 w;
#pragma unroll
                for (int p = 0; p < 4; ++p) { const f32x4 ag = acc[ai][0][m][p >> 1], au = acc[ai][1][m][p >> 1]; const f32x2 g0 = (p & 1) ? hi2(ag) : lo2(ag), u0 = (p & 1) ? hi2(au) : lo2(au);
                    const f32x2 g = fma2(g0, rs2, fma2(a1[0][p], nrm2, a2[0][p])), uu = fma2(u0, rs2, fma2(a1[1][p], nrm2, a2[1][p]));
                    const f32x2 ge = g * sp2(-1.4426950408889634f); f32x2 e; e.x = __builtin_amdgcn_exp2f(ge.x); e.y = __builtin_amdgcn_exp2f(ge.y);
                    const f32x2 dn = e + sp2(1.0f); f32x2 sg; sg.x = __builtin_amdgcn_rcpf(dn.x); sg.y = __builtin_amdgcn_rcpf(dn.y);
                    const f32x2 r = (g * sg) * uu; w[p] = cvt_pk_bf16(r.x, r.y); }
                *(u32x4*)rowp = w; }
    }
};
template <bool RES_F32> struct EpiRes {
    static constexpr bool PERM = true, AFTER_DRAIN = false;
    const float* resf; const bf16_t* resb; const float* ist; const float* lw; const float* lb; bf16_t* out; float* ost; int ldc; float alpha;
    __device__ __forceinline__ void operator()(const f32x4 (&acc)[2][2][4][2], const Unit& u, int wr, int wc, int fr, int fq) const {
        const int rowu = u.pm * BM + wr * 64, col0 = u.pn * BM + wc * 32 + 8 * fq;
        const unsigned vb = (unsigned)(fr * ldc + col0) * 2u, vf = (unsigned)(fr * ldc + col0) * 4u;
        f32x2 wv[2][4], bv[2][4];
#pragma unroll
        for (int bj = 0; bj < 2; ++bj)
#pragma unroll
            for (int n = 0; n < 2; ++n) { f32x4 x1 = (f32x4){alpha, alpha, alpha, alpha}, x2 = (f32x4){0.f, 0.f, 0.f, 0.f};
                if (!RES_F32) { x1 = *(const f32x4*)(lw + col0 + bj * HALF + 4 * n) * alpha; x2 = *(const f32x4*)(lb + col0 + bj * HALF + 4 * n) * alpha; }
                wv[bj][2 * n] = lo2(x1); wv[bj][2 * n + 1] = hi2(x1); bv[bj][2 * n] = lo2(x2); bv[bj][2 * n + 1] = hi2(x2); }
        constexpr int RB = RES_F32 ? 2 : 4;
#pragma unroll
        for (int b0 = 0; b0 < 8; b0 += RB) {
            f32x4 rf[RB][2][2]; u32x4 rb[RB][2];
#pragma unroll
            for (int q = 0; q < RB; ++q) { const int ai = (b0 + q) >> 2, m = (b0 + q) & 3; const size_t rbase = (size_t)(rowu + ai * HALF + m * 16) * ldc;
#pragma unroll
                for (int bj = 0; bj < 2; ++bj) { if (RES_F32) { const char* p = (const char*)(resf + rbase + bj * HALF) + vf; rf[q][bj][0] = *(const f32x4*)p; rf[q][bj][1] = *(const f32x4*)(p + 16); }
                                                 else rb[q][bj] = *(const u32x4*)((const char*)(resb + rbase + bj * HALF) + vb); } }
#pragma unroll
            for (int q = 0; q < RB; ++q) { const int ai = (b0 + q) >> 2, m = (b0 + q) & 3; const int row = rowu + fr + ai * HALF + m * 16; const size_t rbase = (size_t)(rowu + ai * HALF + m * 16) * ldc;
                float mn = 0.f, rs = 1.f; if (!RES_F32) row_stats(ist, row, mn, rs);
                const f32x2 rs2 = sp2(rs), c02 = sp2(-mn * rs);
                f32x2 ps2 = sp2(0.f), pq2 = sp2(0.f);
#pragma unroll
                for (int bj = 0; bj < 2; ++bj) { u32x4 w;
#pragma unroll
                    for (int p = 0; p < 4; ++p) { f32x2 r;
                        if (RES_F32) { const f32x4 x = rf[q][bj][p >> 1]; r = (p & 1) ? hi2(x) : lo2(x); } else r = bf2(rb[q][bj][p]);
                        const f32x4 a4 = acc[ai][bj][m][p >> 1]; const f32x2 a = (p & 1) ? hi2(a4) : lo2(a4);
                        const f32x2 o = fma2(fma2(r, rs2, c02), wv[bj][p], bv[bj][p] + a);
                        w[p] = cvt_pk_bf16(o.x, o.y); ps2 = ps2 + o; pq2 = fma2(o, o, pq2); }
                    *(u32x4*)((char*)(out + rbase + bj * HALF) + vb) = w; }
                float ps = ps2.x + ps2.y, pq = pq2.x + pq2.y;
                ps += __shfl_xor(ps, 16); ps += __shfl_xor(ps, 32); pq += __shfl_xor(pq, 16); pq += __shfl_xor(pq, 32);
                if (fq == 0) { stat_add(ost + 2 * row, ps); stat_add(ost + 2 * row + 1, pq); } }
            asm volatile("" ::: "memory"); }
    }
};
struct EpiGlu {
    static constexpr bool PERM = true, AFTER_DRAIN = false;
    const bf16_t* Z; bf16_t* out; int ldc;
    __device__ __forceinline__ void operator()(const f32x4 (&acc)[2][2][4][2], const Unit& u, int wr, int wc, int fr, int fq) const {
        const int row0 = u.pm * BM + wr * 64 + fr, col0 = u.pn * BM + wc * 32 + 8 * fq;
#pragma unroll
        for (int ai = 0; ai < 2; ++ai)
#pragma unroll
            for (int m = 0; m < 4; ++m) { const size_t off = (size_t)(row0 + ai * HALF + m * 16) * ldc + col0;
#pragma unroll
                for (int bj = 0; bj < 2; ++bj) { const u32x4 zw = *(const u32x4*)(Z + off + bj * HALF); const f32x4 v0 = acc[ai][bj][m][0], v1 = acc[ai][bj][m][1];
                    u32x4 w;
                    w.x = cvt_pk_bf16(__uint_as_float(zw.x << 16) * sigm(v0[0]), __uint_as_float(zw.x & 0xffff0000u) * sigm(v0[1]));
                    w.y = cvt_pk_bf16(__uint_as_float(zw.y << 16) * sigm(v0[2]), __uint_as_float(zw.y & 0xffff0000u) * sigm(v0[3]));
                    w.z = cvt_pk_bf16(__uint_as_float(zw.z << 16) * sigm(v1[0]), __uint_as_float(zw.z & 0xffff0000u) * sigm(v1[1]));
                    w.w = cvt_pk_bf16(__uint_as_float(zw.w << 16) * sigm(v1[2]), __uint_as_float(zw.w & 0xffff0000u) * sigm(v1[3]));
                    *(u32x4*)(out + off + bj * HALF) = w; } }
    }
};
struct EpiPle {
    static constexpr bool PERM = true, AFTER_DRAIN = false;
    const bf16_t* resb; const float* ist; const float* lw; const float* lb; const float* c1; const float* c2; const bf16_t* PI; bf16_t* out; float* ost; int ldc; float alpha;
    __device__ __forceinline__ void operator()(const f32x4 (&acc)[2][2][4][2], const Unit& u, int wr, int wc, int fr, int fq) const {
        const int rowu = u.pm * BM + wr * 64, col0 = u.pn * BM + wc * 32 + 8 * fq; const unsigned vb = (unsigned)(fr * ldc + col0) * 2u;
        constexpr float NL = -1.4426950408889634f;
#pragma unroll
        for (int bj = 0; bj < 2; ++bj) {
            f32x2 k1[4], k2[4], wv[4], bv[4];
#pragma unroll
            for (int n = 0; n < 2; ++n) { const int cc = col0 + bj * HALF + 4 * n; const f32x4 x1 = *(const f32x4*)(c1 + cc), x2 = *(const f32x4*)(c2 + cc) * NL, x3 = *(const f32x4*)(lw + cc) * alpha, x4 = *(const f32x4*)(lb + cc) * alpha;
                k1[2 * n] = lo2(x1); k1[2 * n + 1] = hi2(x1); k2[2 * n] = lo2(x2); k2[2 * n + 1] = hi2(x2); wv[2 * n] = lo2(x3); wv[2 * n + 1] = hi2(x3); bv[2 * n] = lo2(x4); bv[2 * n + 1] = hi2(x4); }
#pragma unroll
            for (int hb = 0; hb < 4; ++hb) { const int ai = hb >> 1;
                u32x4 rwv[2], pwv[2];
#pragma unroll
                for (int mq = 0; mq < 2; ++mq) { const int m = (hb & 1) * 2 + mq; const size_t rbase = (size_t)(rowu + ai * HALF + m * 16) * ldc + bj * HALF; rwv[mq] = *(const u32x4*)((const char*)(resb + rbase) + vb); pwv[mq] = *(const u32x4*)((const char*)(PI + rbase) + vb); }
#pragma unroll
                for (int mq = 0; mq < 2; ++mq) { const int m = (hb & 1) * 2 + mq; const int row = rowu + fr + ai * HALF + m * 16; const size_t rbase = (size_t)(rowu + ai * HALF + m * 16) * ldc + bj * HALF; float mn, rs; row_stats(ist, row, mn, rs);
                    const f32x2 rs2 = sp2(rs), c02 = sp2(-mn * rs), rsl = sp2(rs * NL), rml = sp2(-rs * mn * NL);
                    u32x4 w; f32x2 ps2 = sp2(0.f), pq2 = sp2(0.f);
#pragma unroll
                    for (int p = 0; p < 4; ++p) { const f32x4 a4 = acc[ai][bj][m][p >> 1]; const f32x2 a = (p & 1) ? hi2(a4) : lo2(a4);
                        const f32x2 ge = fma2(a, rsl, fma2(k1[p], rml, k2[p])); f32x2 e; e.x = __builtin_amdgcn_exp2f(ge.x); e.y = __builtin_amdgcn_exp2f(ge.y);
                        const f32x2 dn = e + sp2(1.0f); f32x2 sg; sg.x = __builtin_amdgcn_rcpf(dn.x); sg.y = __builtin_amdgcn_rcpf(dn.y);
                        const f32x2 h = fma2(fma2(bf2(rwv[mq][p]), rs2, c02), wv[p], bv[p]);
                        const f32x2 o = fma2(bf2(pwv[mq][p]), sg, h);
                        w[p] = cvt_pk_bf16(o.x, o.y); ps2 = ps2 + o; pq2 = fma2(o, o, pq2); }
                    *(u32x4*)((char*)(out + rbase) + vb) = w;
                    float a = ps2.x + ps2.y, b = pq2.x + pq2.y;
                    a += __shfl_xor(a, 16); a += __shfl_xor(a, 32); b += __shfl_xor(b, 16); b += __shfl_xor(b, 32);
                    if (fq == 0) { stat_add(ost + 2 * row, a); stat_add(ost + 2 * row + 1, b); } }
                asm volatile("" ::: "memory"); }
        }
    }
};
template <class Epi, class Sched, bool ALIGN_EPI = false, bool SP2 = false>
__device__ __forceinline__ void gemm_phase(PG8_LAS unsigned char* lds, const Gemm g, const Sched& S, const Epi& E) {
    int tid_ = threadIdx.x; asm volatile("" : "+v"(tid_));
    const int tid = tid_, wid = __builtin_amdgcn_readfirstlane(tid >> 6), lane = tid & 63, wr = wid >> 2, wc = wid & 3, fr = lane & 15, fq = lane >> 4;
    const int K = g.K, nt = K / BK;
    unsigned voffA[2], voffB[2];
#pragma unroll
    for (int i = 0; i < 2; ++i) { int R, C; stage_rc(tid * 16 + i * 8192, R, C); const int Rb = Epi::PERM ? ((R & ~31) + perm32(R & 31)) : R;
        voffA[i] = (unsigned)(R * K + C) * 2u; voffB[i] = (unsigned)(Rb * K + C) * 2u; }
    const size_t kstep = (size_t)(BK * 2);
    const size_t hstep = (size_t)HALF * K * 2;
    const size_t tstep = 2 * hstep;
    const unsigned ldsw = (unsigned)wid * 1024u;
    const int aoff = lds_byte(wr * 64 + fr, fq * 8), boff = lds_byte(wc * 32 + fr, fq * 8);
#define PG8_SA(b, h) (((b) * 2 + (h)) * HTB)
#define PG8_SB(b, h) ((4 + (b) * 2 + (h)) * HTB)
#define PG8_STAGE(bufoff, gbase, voff) do { _Pragma("unroll") for (int _i = 0; _i < 2; ++_i) \
        __builtin_amdgcn_global_load_lds((const unsigned*)((const char*)(gbase) + (voff)[_i]), (PG8_LAS unsigned*)(lds + (bufoff) + ldsw + _i * 8192), 16, 0, 0); } while (0)
#define PG8_LDA(dst, b, h) do { _Pragma("unroll") for (int m = 0; m < 4; ++m) _Pragma("unroll") for (int k = 0; k < 2; ++k) dst[m][k] = *(const PG8_LAS bf16x8*)(lds + PG8_SA(b, h) + aoff + m * 2048 + k * 1024); } while (0)
#define PG8_LDB(dst, b, h) do { _Pragma("unroll") for (int n = 0; n < 2; ++n) _Pragma("unroll") for (int k = 0; k < 2; ++k) dst[n][k] = *(const PG8_LAS bf16x8*)(lds + PG8_SB(b, h) + boff + n * 2048 + k * 1024); } while (0)
#define PG8_MMA(ai, bj, At, Bt) do { __builtin_amdgcn_s_setprio(1); _Pragma("unroll") for (int m = 0; m < 4; ++m) _Pragma("unroll") for (int n = 0; n < 2; ++n) _Pragma("unroll") for (int k = 0; k < 2; ++k) \
        acc[ai][bj][m][n] = __builtin_amdgcn_mfma_f32_16x16x32_bf16(Bt[n][k], At[m][k], acc[ai][bj][m][n], 0, 0, 0); __builtin_amdgcn_s_setprio(0); } while (0)
#define PG8_WAIT_V(n) asm volatile("s_waitcnt vmcnt(" #n ")" ::: "memory")
#define PG8_WAIT_L(n) asm volatile("s_waitcnt lgkmcnt(" #n ")" ::: "memory")
#define PG8_BAR __builtin_amdgcn_s_barrier()
#define PG8_SCHED __builtin_amdgcn_sched_barrier(0)
    Unit cur, nxt; int ui = 0;
    if (!S.next(0, cur)) return;
    f32x4 acc[2][2][4][2];
#pragma unroll
    for (int a = 0; a < 2; ++a)
#pragma unroll
        for (int b = 0; b < 2; ++b)
#pragma unroll
            for (int m = 0; m < 4; ++m)
#pragma unroll
                for (int n = 0; n < 2; ++n) acc[a][b][m][n] = (f32x4){0.f, 0.f, 0.f, 0.f};
    bf16x8 At[4][2], B0[2][2], B1[2][2];
    const char* cA = (const char*)g.A + (size_t)cur.pm * tstep; const char* cB = (const char*)g.Bt + (size_t)cur.pn * tstep;
    S.a_ready(cur);
    if constexpr (SP2) {
        PG8_STAGE(PG8_SB(0, 0), cB, voffB); PG8_STAGE(PG8_SB(0, 1), cB + hstep, voffB); PG8_STAGE(PG8_SA(0, 0), cA, voffA); PG8_STAGE(PG8_SA(0, 1), cA + hstep, voffA);
        if (wr == 1) PG8_BAR;
        PG8_WAIT_V(2); PG8_BAR;
        PG8_STAGE(PG8_SB(1, 0), cB + kstep, voffB); PG8_STAGE(PG8_SA(1, 0), cA + kstep, voffA); PG8_STAGE(PG8_SB(1, 1), cB + hstep + kstep, voffB);
        PG8_WAIT_V(6); PG8_BAR;
    } else {
        PG8_STAGE(PG8_SB(0, 0), cB, voffB); PG8_STAGE(PG8_SA(0, 0), cA, voffA); PG8_STAGE(PG8_SB(0, 1), cB + hstep, voffB); PG8_STAGE(PG8_SA(0, 1), cA + hstep, voffA);
        if (wr == 1) PG8_BAR;
        PG8_WAIT_V(4); PG8_BAR;
        PG8_STAGE(PG8_SB(1, 0), cB + kstep, voffB); PG8_STAGE(PG8_SA(1, 0), cA + kstep, voffA); PG8_STAGE(PG8_SB(1, 1), cB + hstep + kstep, voffB);
        PG8_WAIT_V(6); PG8_BAR;
    }
    for (;;) {
        const bool has_next = S.next(ui + 1, nxt);
        const char* nA = has_next ? (const char*)g.A + (size_t)nxt.pm * tstep : cA; const char* nB = has_next ? (const char*)g.Bt + (size_t)nxt.pn * tstep : cB;
        for (int t = 0; t < nt; t += 2) {
            const bool last = (t == nt - 2);
            const char* a1 = cA + (size_t)(t + 1) * kstep;
            const char* a2 = last ? nA : cA + (size_t)(t + 2) * kstep; const char* b2 = last ? nB : cB + (size_t)(t + 2) * kstep;
            const char* a3 = a2 + kstep; const char* b3 = b2 + kstep;
            if (last && has_next) S.a_ready(nxt);
            if constexpr (SP2) {
            PG8_LDB(B0, 0, 0); PG8_LDB(B1, 0, 1); PG8_SCHED; PG8_LDA(At, 0, 0); PG8_STAGE(PG8_SA(1, 1), a1 + hstep, voffA);
            PG8_WAIT_V(8); PG8_WAIT_L(0); PG8_BAR; PG8_MMA(0, 0, At, B0); PG8_MMA(0, 1, At, B1); PG8_BAR; PG8_SCHED;
            PG8_LDA(At, 0, 1); PG8_STAGE(PG8_SB(0, 0), b2, voffB); PG8_STAGE(PG8_SB(0, 1), b2 + hstep, voffB); PG8_STAGE(PG8_SA(0, 0), a2, voffA);
            PG8_WAIT_V(8); PG8_WAIT_L(0); PG8_BAR; PG8_MMA(1, 0, At, B0); PG8_MMA(1, 1, At, B1); PG8_BAR; PG8_SCHED;
            PG8_LDB(B0, 1, 0); PG8_LDB(B1, 1, 1); PG8_SCHED; PG8_LDA(At, 1, 0); PG8_STAGE(PG8_SA(0, 1), a2 + hstep, voffA);
            PG8_WAIT_V(8); PG8_WAIT_L(0); PG8_BAR; PG8_MMA(0, 0, At, B0); PG8_MMA(0, 1, At, B1); PG8_BAR; PG8_SCHED;
            PG8_LDA(At, 1, 1); PG8_STAGE(PG8_SB(1, 0), b3, voffB); PG8_STAGE(PG8_SB(1, 1), b3 + hstep, voffB); PG8_STAGE(PG8_SA(1, 0), a3, voffA);
            PG8_WAIT_V(8); PG8_WAIT_L(0); PG8_BAR; PG8_MMA(1, 0, At, B0); PG8_MMA(1, 1, At, B1); PG8_BAR; PG8_SCHED;
            } else {
            PG8_LDB(B0, 0, 0); PG8_SCHED; PG8_LDA(At, 0, 0); PG8_STAGE(PG8_SA(1, 1), a1 + hstep, voffA);
            PG8_WAIT_L(8); PG8_BAR; PG8_WAIT_L(0); PG8_MMA(0, 0, At, B0); PG8_BAR; PG8_SCHED;
            PG8_LDB(B1, 0, 1); PG8_STAGE(PG8_SB(0, 0), b2, voffB);
            PG8_BAR; PG8_WAIT_L(0); PG8_MMA(0, 1, At, B1); PG8_BAR;
            PG8_LDA(At, 0, 1); PG8_STAGE(PG8_SA(0, 0), a2, voffA);
            PG8_BAR; PG8_WAIT_L(0); PG8_MMA(1, 0, At, B0); PG8_BAR; PG8_SCHED;
            PG8_STAGE(PG8_SB(0, 1), b2 + hstep, voffB);
            PG8_WAIT_V(6); PG8_BAR; PG8_MMA(1, 1, At, B1); PG8_BAR;
            PG8_LDB(B0, 1, 0); PG8_SCHED; PG8_LDA(At, 1, 0); PG8_STAGE(PG8_SA(0, 1), a2 + hstep, voffA);
            PG8_WAIT_L(8); PG8_BAR; PG8_WAIT_L(0); PG8_MMA(0, 0, At, B0); PG8_BAR; PG8_SCHED;
            PG8_LDB(B1, 1, 1); PG8_STAGE(PG8_SB(1, 0), b3, voffB);
            PG8_BAR; PG8_WAIT_L(0); PG8_MMA(0, 1, At, B1); PG8_BAR;
            PG8_LDA(At, 1, 1); PG8_STAGE(PG8_SA(1, 0), a3, voffA);
            PG8_BAR; PG8_WAIT_L(0); PG8_MMA(1, 0, At, B0); PG8_BAR; PG8_SCHED;
            PG8_STAGE(PG8_SB(1, 1), b3 + hstep, voffB);
            PG8_WAIT_V(6); PG8_BAR; PG8_MMA(1, 1, At, B1); PG8_BAR;
            }
        }
        if constexpr (ALIGN_EPI) { if (wr == 0) PG8_BAR; }
        if constexpr (!Epi::AFTER_DRAIN) { E(acc, cur, wr, wc, fr, fq); S.done(cur); }
        if (!has_next) break;
#pragma unroll
        for (int a = 0; a < 2; ++a)
#pragma unroll
            for (int b = 0; b < 2; ++b)
#pragma unroll
                for (int m = 0; m < 4; ++m)
#pragma unroll
                    for (int n = 0; n < 2; ++n) acc[a][b][m][n] = (f32x4){0.f, 0.f, 0.f, 0.f};
        cur = nxt; cA = nA; cB = nB; ++ui;
        if constexpr (ALIGN_EPI) { if (wr == 1) PG8_BAR; }
    }
    PG8_WAIT_V(0);
    if constexpr (!ALIGN_EPI) { if (wr == 0) PG8_BAR; }
    PG8_BAR;
    if constexpr (Epi::AFTER_DRAIN) { E.fused(acc, cur, wr, wc, fr, fq, lds, wid, lane); S.done(cur); }
#undef PG8_SA
#undef PG8_SB
#undef PG8_STAGE
#undef PG8_LDA
#undef PG8_LDB
#undef PG8_MMA
#undef PG8_WAIT_V
#undef PG8_WAIT_L
#undef PG8_BAR
#undef PG8_SCHED
}
}
#ifndef PROBE_SPAN
#define PROBE_SPAN 0
#endif
constexpr int NWAVES = 8;
constexpr int D = 4096, BATCH = 4, SEQ = 4096, M = BATCH * SEQ, DEPTH = 2;
constexpr int S5W = 1024, SGW = 1024, HGW = 2048, PROJ = 11264, DFF = 11008, PLE = 256;
constexpr int C_XA = 0, C_U = 1024, C_V = 2048, C_Q = 3072, C_F = 5120, C_I = 7168, C_G = 9216;
constexpr float LN_EPS = 1e-5f, RMS_EPS = 1e-6f;
constexpr float ALPHA = 1.4142135623730951f;
enum { I_X = 0, I_P, I_WIN, I_LAMRE, I_LAMIM, I_LOGSTEP, I_BRE, I_BIM, I_CRE, I_CIM, I_S5D, I_WGLU, I_SGLNW, I_SGLNB, I_SGW, I_SGB, I_HGLB, I_HGNW, I_NAW, I_NBW, I_WOUT, I_LN1W, I_LN1B,
       I_WFI, I_WFO, I_LN2W, I_LN2B, I_WPI, I_WPG, I_LN3W, I_LN3B, N_IN };
constexpr size_t MiB = 1u << 20;
constexpr size_t WS_CTL = 0, CTL_ZERO_BYTES = 2 * MiB;
constexpr size_t CTL_STATS = 64 * 1024, STATS_BYTES = (size_t)16384 * 2 * 4;
constexpr size_t CTL_CVEC = CTL_STATS + 6 * STATS_BYTES;
constexpr int CV_IN = 0, CV_FI = 11264, CV_PG = 11264 + 22016, CV_N = 11264 + 22016 + 4096;
static_assert(CTL_CVEC + (size_t)2 * 2 * CV_N * 4 <= CTL_ZERO_BYTES, "control region");
constexpr size_t CTL_SGST = 1536 * 1024;
static_assert(CTL_CVEC + (size_t)2 * 2 * CV_N * 4 <= CTL_SGST && CTL_SGST + (size_t)2 * 16384 * 2 * 4 <= CTL_ZERO_BYTES, "control region");
constexpr size_t WS_CVP_ = (size_t)(2258 + 1 + 32 + 32 + 16 + 16) * MiB;
constexpr int CV_KB = 64;

constexpr size_t WS_W = 2 * MiB, WL_STRIDE = 416 * MiB;
constexpr size_t WO_IN = 0, WO_GLU = 88 * MiB, WO_OUT = 90 * MiB, WO_FI = 122 * MiB, WO_FO = 294 * MiB, WO_PI = 380 * MiB, WO_PG = 382 * MiB;
constexpr size_t WS_PB = WS_W + 2 * WL_STRIDE;
constexpr size_t WS_HF = WS_PB + 16 * MiB;
constexpr size_t WS_HB = WS_HF + 256 * MiB;
constexpr size_t WS_T = WS_HB + 128 * MiB;
constexpr size_t WS_PROJ = WS_T + 256 * MiB;
constexpr size_t WS_CAT = WS_PROJ + 352 * MiB;
constexpr size_t WS_Z = WS_CAT + 128 * MiB;
constexpr size_t WS_ZA = WS_Z + 32 * MiB;
constexpr size_t WS_UZ = WS_ZA + 64 * MiB;
constexpr size_t WS_O = WS_UZ + 64 * MiB;
constexpr size_t WS_STAT = WS_O + 128 * MiB;
constexpr size_t WS_LNS = WS_STAT + 512 * 1024;
constexpr size_t WS_END = WS_STAT + 1 * MiB;
constexpr int CW_BAR = 4096;
constexpr int CW_TEAM = 12288;
constexpr int CW_GRP = 8192;

constexpr int RING_OFF = 0, RING_BYTES = 131072;
constexpr int LDSCTL_OFF = RING_BYTES, MISC_OFF = LDSCTL_OFF + 320;
constexpr int STATL_OFF = 147456;
constexpr int LDS_BYTES = 163840;
#define GAS __attribute__((address_space(1)))
#define LAS __attribute__((address_space(3)))
typedef unsigned short bf16;
typedef unsigned v4u __attribute__((ext_vector_type(4)));
typedef float f32x4 __attribute__((ext_vector_type(4)));
typedef short bf16x8 __attribute__((ext_vector_type(8)));
typedef GAS unsigned gu32;
typedef GAS unsigned long long gu64;
#define RLX_AGENT __ATOMIC_RELAXED, __HIP_MEMORY_SCOPE_AGENT
#define LDS_WAIT() asm volatile("s_waitcnt lgkmcnt(0)" ::: "memory")
#define VM_WAIT() asm volatile("s_waitcnt vmcnt(0)" ::: "memory")
__device__ __forceinline__ unsigned long long rt() { return __builtin_amdgcn_s_memrealtime(); }
typedef float f32x2_t __attribute__((ext_vector_type(2)));
typedef __bf16 bf16x2_t __attribute__((ext_vector_type(2)));
__device__ __forceinline__ unsigned pk2(float lo, float hi) { const f32x2_t v = {lo, hi}; return __builtin_bit_cast(unsigned, __builtin_convertvector(v, bf16x2_t)); }
__device__ __forceinline__ unsigned f2bf(float f) { return pk2(f, 0.f) & 0xffffu; }

#define XB_TMO      128
#define XB_XCNT(j)  (256  + 64 * (j))
#define XB_XSUB(j)  (1280 + 64 * (j))
#define XB_XGEN(j)  (2304 + 64 * (j))
#define XB_TOP      3328
#define XB_TOPGEN   3392
#define XCD_BAR_WORDS 3456
#define XB_SPIN_CAP (1u << 18)

__device__ __forceinline__ unsigned xb_ld(unsigned* p)              { return __hip_atomic_load(p, __ATOMIC_RELAXED, __HIP_MEMORY_SCOPE_AGENT); }
__device__ __forceinline__ unsigned xb_add(unsigned* p, unsigned v) { return __hip_atomic_fetch_add(p, v, __ATOMIC_RELAXED, __HIP_MEMORY_SCOPE_AGENT); }
__device__ __forceinline__ unsigned xb_xcc_id() { return (unsigned)__builtin_amdgcn_s_getreg((3 << 11) | 20) & 0xFu; }
#define XB_SPIN(cond, bar) do { unsigned _sp = 0; while (cond) { __builtin_amdgcn_s_sleep(1); \
    if ((++_sp & 255u) == 0u) { if (xb_ld(&(bar)[XB_TMO])) break; if (_sp > XB_SPIN_CAP) { atomicAdd(&(bar)[XB_TMO], 1u); break; } } } } while (0)

struct XcdBarrier {
    unsigned* bar; unsigned x;
    volatile LAS unsigned* st;
};

__device__ __forceinline__ XcdBarrier xcd_barrier_post(unsigned* bar, volatile LAS unsigned* st) {
    XcdBarrier b; b.bar = bar; b.x = xb_xcc_id(); b.st = st;
    if (threadIdx.x == 0) (void)xb_add(&bar[XB_XCNT(b.x)], 1u);
    return b;
}
__device__ __forceinline__ void xcd_barrier_complete(unsigned* bar, unsigned x, unsigned& nloc, unsigned& nx) {
    const unsigned G = gridDim.x * gridDim.y * gridDim.z;
    unsigned sum, cnt, mine, sp = 0u;
    for (;;) {
        sum = 0u; cnt = 0u; mine = 0u;
#pragma unroll
        for (unsigned j = 0; j < 16; ++j) { const unsigned c = xb_ld(&bar[XB_XCNT(j)]); sum += c; cnt += (c > 0u) ? 1u : 0u; mine = (j == x) ? c : mine; }
        if (sum == G) break;
        __builtin_amdgcn_s_sleep(1);
        if ((++sp & 255u) == 0u) { if (xb_ld(&bar[XB_TMO])) break; if (sp > XB_SPIN_CAP) { atomicAdd(&bar[XB_TMO], 1u); break; } }
    }
    nloc = mine > 0u ? mine : 1u; nx = cnt > 0u ? cnt : 1u;
}

__device__ __forceinline__ void xcd_barrier(const XcdBarrier& b) {
    asm volatile("s_waitcnt vmcnt(0)" ::: "memory");
    __syncthreads();
    if (threadIdx.x == 0) {
        unsigned* bar = b.bar; const unsigned bx = xb_xcc_id();
        __builtin_amdgcn_s_waitcnt(0);
        unsigned nloc = b.st[0], nx = b.st[1];
        if (nloc == 0u) { xcd_barrier_complete(bar, bx, nloc, nx); b.st[0] = nloc; b.st[1] = nx; }
        const unsigned old = xb_add(&bar[XB_XSUB(bx)], 1u);
        const unsigned gen = old / nloc;
        if (old + 1u == (gen + 1u) * nloc) {
            __builtin_amdgcn_fence(__ATOMIC_RELEASE, "agent");
            asm volatile("s_waitcnt vmcnt(0)" ::: "memory");
            const unsigned og = xb_add(&bar[XB_TOP], 1u);
            const unsigned tg = og / nx;
            if (og + 1u == (tg + 1u) * nx) xb_add(&bar[XB_TOPGEN], 1u);
            else XB_SPIN(xb_ld(&bar[XB_TOPGEN]) == tg, bar);
            __builtin_amdgcn_fence(__ATOMIC_ACQUIRE, "agent");
            xb_add(&bar[XB_XGEN(bx)], 1u);
            asm volatile("s_waitcnt vmcnt(0)" ::: "memory");
        } else {
            XB_SPIN(xb_ld(&bar[XB_XGEN(bx)]) == gen, bar);
            __builtin_amdgcn_fence(__ATOMIC_ACQUIRE, "agent");
            asm volatile("s_waitcnt vmcnt(0)" ::: "memory");
        }
    }
    __syncthreads();
}


__device__ __forceinline__ void grp_barrier(unsigned* cnt  , unsigned nmem, unsigned* tmo) {
    asm volatile("s_waitcnt vmcnt(0)" ::: "memory");
    __syncthreads();
    if (threadIdx.x == 0) {
        __builtin_amdgcn_s_waitcnt(0);
        const unsigned old = xb_add(cnt, 1u); const unsigned target = (old / nmem + 1u) * nmem;
        XB_SPIN(xb_ld(cnt) < target, tmo);
        __builtin_amdgcn_fence(__ATOMIC_ACQUIRE, "agent");
        asm volatile("s_waitcnt vmcnt(0)" ::: "memory");
    }
    __syncthreads();
}
struct KArgs { const float* in[N_IN]; float* out; unsigned char* ws; unsigned long long rep; int ph_lo, ph_hi; };
constexpr int ARGTAB_OFF = LDSCTL_OFF + 1024;
struct InTab { LAS const unsigned* t;
    __device__ __forceinline__ const float* operator[](int i) const { const unsigned lo = t[2 * i], hi = t[2 * i + 1];
        return (const float*)(((unsigned long long)(unsigned)__builtin_amdgcn_readfirstlane((int)hi) << 32) | (unsigned)__builtin_amdgcn_readfirstlane((int)lo)); } };
struct Args { InTab in; float* out; unsigned char* ws; unsigned long long rep; int ph_lo, ph_hi; };
struct Frame {
    LAS unsigned char* lds;
    int wave, vcu, G;
    unsigned long long pr_acc; bool pr_me;
};
#define LDS_BARRIER() do { asm volatile("s_waitcnt lgkmcnt(0)" ::: "memory"); __builtin_amdgcn_s_barrier(); asm volatile("" ::: "memory"); } while (0)
__device__ __forceinline__ int lane_now() { int l = (int)__builtin_amdgcn_mbcnt_hi(~0u, __builtin_amdgcn_mbcnt_lo(~0u, 0u)); asm volatile("" : "+v"(l)); return l; }
__device__ __forceinline__ int bid_now() { int b = (int)blockIdx.x; asm volatile("" : "+s"(b)); return b; }
__device__ __forceinline__ int opaque(int v) { asm volatile("" : "+v"(v)); return v; }
__device__ __forceinline__ int tid_now(const Frame& F) { return F.wave * 64 + lane_now(); }
__device__ __forceinline__ float wave_sum(float v) {
#pragma unroll
    for (int o = 1; o < 64; o <<= 1) v += __shfl_xor(v, o);
    return v;
}
__device__ __forceinline__ float bflo(unsigned w) { return __uint_as_float(w << 16); }
__device__ __forceinline__ float bfhi(unsigned w) { return __uint_as_float(w & 0xffff0000u); }
__device__ __forceinline__ float bf1(bf16 h) { return __uint_as_float(((unsigned)h) << 16); }
__device__ __forceinline__ float sigmoid_f(float x) { return __builtin_amdgcn_rcpf(1.0f + __builtin_amdgcn_exp2f(-1.4426950408889634f * x)); }
__device__ __forceinline__ float silu_f(float x) { return x * sigmoid_f(x); }
__device__ __forceinline__ float gelu_f(float x) { const float x2 = x * x; const float a2 = x * (-2.302208198f - 0.102943240f * x2);
    return x * __builtin_amdgcn_rcpf(1.0f + __builtin_amdgcn_exp2f(a2)); }

struct P0Item { const float* W; bf16* WT; int K, N, swz, r; const float* lnw; const float* lnb; float* c1; float* c2; };
__device__ __forceinline__ P0Item p0_item(const Args& A, int it) {
    constexpr int IT_IN = (D / 64) * (PROJ / 32), IT_GLU = (S5W / 64) * (S5W / 32), IT_OUT = (D / 64) * (D / 32), IT_FI = (D / 64) * (2 * DFF / 32), IT_FO = (DFF / 64) * (D / 32), IT_PI = (PLE / 64) * (D / 32), IT_PG = IT_OUT;
    constexpr int IT_L = IT_IN + IT_GLU + IT_OUT + IT_FI + IT_FO + IT_PI + IT_PG;
    const int l = it / IT_L; int r = it % IT_L; unsigned char* wl = A.ws + WS_W + (size_t)l * WL_STRIDE; P0Item I;
    float* cv = (float*)(A.ws + WS_CVP_) + (size_t)l * CV_KB * 2 * CV_N; const float* nul = nullptr; float* nulw = nullptr;
    if (r < IT_IN) { I = P0Item{A.in[I_WIN] + (size_t)l * D * PROJ, (bf16*)(wl + WO_IN), D, PROJ, 0, r, l ? A.in[I_LN3W] + (l - 1) * D : nul, l ? A.in[I_LN3B] + (l - 1) * D : nul, l ? cv + CV_IN : nulw, l ? cv + CV_N + CV_IN : nulw}; return I; } r -= IT_IN;
    if (r < IT_GLU) { I = P0Item{A.in[I_WGLU] + (size_t)l * S5W * S5W, (bf16*)(wl + WO_GLU), S5W, S5W, 0, r, nul, nul, nulw, nulw}; return I; } r -= IT_GLU;
    if (r < IT_OUT) { I = P0Item{A.in[I_WOUT] + (size_t)l * D * D, (bf16*)(wl + WO_OUT), D, D, 0, r, nul, nul, nulw, nulw}; return I; } r -= IT_OUT;
    if (r < IT_FI) { I = P0Item{A.in[I_WFI] + (size_t)l * D * 2 * DFF, (bf16*)(wl + WO_FI), D, 2 * DFF, 1, r, A.in[I_LN1W] + l * D, A.in[I_LN1B] + l * D, cv + CV_FI, cv + CV_N + CV_FI}; return I; } r -= IT_FI;
    if (r < IT_FO) { I = P0Item{A.in[I_WFO] + (size_t)l * DFF * D, (bf16*)(wl + WO_FO), DFF, D, 0, r, nul, nul, nulw, nulw}; return I; } r -= IT_FO;
    if (r < IT_PI) { I = P0Item{A.in[I_WPI] + (size_t)l * PLE * D, (bf16*)(wl + WO_PI), PLE, D, 0, r, nul, nul, nulw, nulw}; return I; } r -= IT_PI;
    I = P0Item{A.in[I_WPG] + (size_t)l * D * D, (bf16*)(wl + WO_PG), D, D, 0, r, A.in[I_LN2W] + l * D, A.in[I_LN2B] + l * D, cv + CV_PG, cv + CV_N + CV_PG}; return I;
}
__device__ __forceinline__ void p0_load(const P0Item& I, int lane, float (&rg)[32]) {
    const int nblk = I.N / 32, kb = I.r / nblk, nb = I.r % nblk; const float* p = I.W + (size_t)(64 * kb + (lane >> 5)) * I.N + 32 * nb + (lane & 31);
#pragma unroll
    for (int i = 0; i < 32; ++i) rg[i] = p[(size_t)(2 * i) * I.N];
}
__device__ __forceinline__ void p0_store(const P0Item& I, int lane, const float (&rg)[32], LAS float* scr) {
    const int nblk = I.N / 32, kb = I.r / nblk, nb = I.r % nblk, k0 = 64 * kb, n0 = 32 * nb;
#pragma unroll
    for (int i = 0; i < 32; ++i) scr[(2 * i + (lane >> 5)) * 33 + (lane & 31)] = rg[i];
    LDS_WAIT(); asm volatile("" ::: "memory");
    const int c = lane & 7;
    int r0 = n0;
    if (I.swz) { r0 = (n0 < DFF) ? (n0 / 128) * 256 + (n0 % 128) : ((n0 - DFF) / 128) * 256 + 128 + ((n0 - DFF) % 128); }
    f32x4 g0 = (f32x4){1.f, 1.f, 1.f, 1.f}, g1 = g0, h0 = (f32x4){0.f, 0.f, 0.f, 0.f}, h1 = h0;
    if (I.lnw) { g0 = *(const f32x4*)(I.lnw + k0 + 8 * c); g1 = *(const f32x4*)(I.lnw + k0 + 8 * c + 4); h0 = *(const f32x4*)(I.lnb + k0 + 8 * c); h1 = *(const f32x4*)(I.lnb + k0 + 8 * c + 4); }
#pragma unroll
    for (int j = 0; j < 4; ++j) { const int n = (lane >> 3) + 8 * j; const LAS float* s = scr + (8 * c) * 33 + n;
        const float w0 = s[0 * 33], w1 = s[1 * 33], w2 = s[2 * 33], w3 = s[3 * 33], w4 = s[4 * 33], w5 = s[5 * 33], w6 = s[6 * 33], w7 = s[7 * 33];
        v4u o; o.x = pk2(w0 * g0[0], w1 * g0[1]); o.y = pk2(w2 * g0[2], w3 * g0[3]); o.z = pk2(w4 * g1[0], w5 * g1[1]); o.w = pk2(w6 * g1[2], w7 * g1[3]);
        *(GAS v4u*)(I.WT + (size_t)(r0 + n) * I.K + k0 + 8 * c) = o;
        if (I.lnw) {
            float s1 = ((bflo(o.x) + bfhi(o.x)) + (bflo(o.y) + bfhi(o.y))) + ((bflo(o.z) + bfhi(o.z)) + (bflo(o.w) + bfhi(o.w)));
            float s2 = ((w0 * h0[0] + w1 * h0[1]) + (w2 * h0[2] + w3 * h0[3])) + ((w4 * h1[0] + w5 * h1[1]) + (w6 * h1[2] + w7 * h1[3]));
            s1 += __shfl_xor(s1, 1); s1 += __shfl_xor(s1, 2); s1 += __shfl_xor(s1, 4); s2 += __shfl_xor(s2, 1); s2 += __shfl_xor(s2, 2); s2 += __shfl_xor(s2, 4);
            if (c == 0) { I.c1[(size_t)kb * 2 * CV_N + r0 + n] = s1; I.c2[(size_t)kb * 2 * CV_N + r0 + n] = s2; } } }
    LDS_WAIT(); asm volatile("" ::: "memory");
}
__device__ __forceinline__ void p0_prologue(const Args& A, Frame& F) {
    LAS float* scr = (LAS float*)(F.lds + RING_OFF + F.wave * 16384);
    const int gw = F.vcu * NWAVES + F.wave, NGW = F.G * NWAVES; const int lane = lane_now();
    constexpr int IT_IN = (D / 64) * (PROJ / 32), IT_GLU = (S5W / 64) * (S5W / 32), IT_OUT = (D / 64) * (D / 32), IT_FI = (D / 64) * (2 * DFF / 32), IT_FO = (DFF / 64) * (D / 32), IT_PI = (PLE / 64) * (D / 32), IT_PG = IT_OUT;
    constexpr int NIT = DEPTH * (IT_IN + IT_GLU + IT_OUT + IT_FI + IT_FO + IT_PI + IT_PG);
    int it = gw, itEnd = NIT, stride = NGW;
    if (F.G == 256) { constexpr int NB = DEPTH * 64, NITA = (int)(0.5160 * NIT);
        if (F.vcu >= NB) { it = (F.vcu - NB) * NWAVES + F.wave; itEnd = NITA; stride = (F.G - NB) * NWAVES; } else { it = NITA + gw; itEnd = NIT; stride = NB * NWAVES; } }
    {   float ra[32], rb[32];
        if (it < itEnd) { P0Item I0 = p0_item(A, it); p0_load(I0, lane, ra);
            for (;;) {
                const int it1 = it + stride; P0Item I1 = I0; if (it1 < itEnd) { I1 = p0_item(A, it1); p0_load(I1, lane, rb); }
                p0_store(I0, lane, ra, scr);
                if (it1 >= itEnd) break;
                const int it2 = it1 + stride; if (it2 < itEnd) { I0 = p0_item(A, it2); p0_load(I0, lane, ra); }
                p0_store(I1, lane, rb, scr);
                if (it2 >= itEnd) break;
                it = it2;
            } }
    }
    { const float* x = A.in[I_X]; bf16* hb = (bf16*)(A.ws + WS_HB); const size_t n8 = (size_t)M * D / 8;
#pragma unroll 4
      for (size_t i = (size_t)gw * 64 + lane; i < n8; i += (size_t)NGW * 64) { const f32x4 a = *(const f32x4*)(x + i * 8), b = *(const f32x4*)(x + i * 8 + 4);
          v4u o; o.x = pk2(a[0], a[1]); o.y = pk2(a[2], a[3]); o.z = pk2(b[0], b[1]); o.w = pk2(b[2], b[3]); *(v4u*)(hb + i * 8) = o; } }
    { const float* p = A.in[I_P]; bf16* pb = (bf16*)(A.ws + WS_PB); const size_t n8 = (size_t)DEPTH * M * PLE / 8;
#pragma unroll 4
      for (size_t i = (size_t)gw * 64 + lane; i < n8; i += (size_t)NGW * 64) { const f32x4 a = *(const f32x4*)(p + i * 8), b = *(const f32x4*)(p + i * 8 + 4);
          v4u o; o.x = pk2(a[0], a[1]); o.y = pk2(a[2], a[3]); o.z = pk2(b[0], b[1]); o.w = pk2(b[2], b[3]); *(v4u*)(pb + i * 8) = o; } }
}

__device__ __forceinline__ void stats_to_lds(Frame& F, const float* st) {
    typedef float f32x2l __attribute__((ext_vector_type(2)));
    const int tid = tid_now(F), x = bid_now() & 7; LAS f32x2l* T = (LAS f32x2l*)(F.lds + STATL_OFF);
#pragma unroll
    for (int i = 0; i < 4; ++i) { const int r = tid + 512 * i; const f32x2l v = *(const f32x2l*)(st + 2 * (size_t)(2048 * x + r));
        const float mean = v[0] * (1.0f / D), var = fmaxf(v[1] * (1.0f / D) - mean * mean, 0.f); T[r] = (f32x2l){mean, 1.0f / sqrtf(var + LN_EPS)}; }
    __syncthreads();
}
__device__ __forceinline__ void cvec_reduce(const Args& A, int gw, int NGW, int lane) {
    const float* P = (const float*)(A.ws + WS_CVP_); float* C = (float*)(A.ws + WS_CTL + CTL_CVEC);
    for (int i = gw * 64 + lane; i < DEPTH * 2 * CV_N; i += NGW * 64) { const int l = i / (2 * CV_N), r = i % (2 * CV_N); const float* p = P + (size_t)l * CV_KB * 2 * CV_N + r; float s = 0.f;
#pragma unroll
        for (int kb = 0; kb < CV_KB; ++kb) s += p[(size_t)kb * 2 * CV_N];
        C[i] = s; }
}

__device__ __forceinline__ void ln_phase(Frame& F, const bf16* T, const float* w, const float* b, float* outF, bf16* outB, float* stats) {
    const int gw = F.vcu * NWAVES + F.wave, NGW = F.G * NWAVES; const int lane = lane_now(), tid = tid_now(F);
    LAS f32x4* WL4 = (LAS f32x4*)(F.lds + RING_OFF); LAS f32x4* BL4 = WL4 + D / 4;
    for (int i = tid; i < D / 4; i += NWAVES * 64) { WL4[i] = ((const f32x4*)w)[i]; BL4[i] = ((const f32x4*)b)[i]; }
    __syncthreads();
    v4u rc[8], rn[8];
    int m = gw;
    if (m < M) {
#pragma unroll
        for (int j = 0; j < 8; ++j) rc[j] = *(const v4u*)(T + (size_t)m * D + 512 * j + 8 * lane);
    }
    while (m < M) {
        const int mn = m + NGW;
        if (mn < M) {
#pragma unroll
            for (int j = 0; j < 8; ++j) rn[j] = *(const v4u*)(T + (size_t)mn * D + 512 * j + 8 * lane);
        }
        float v[8][8]; float s = 0.f;
#pragma unroll
        for (int j = 0; j < 8; ++j) { v[j][0] = bflo(rc[j].x); v[j][1] = bfhi(rc[j].x); v[j][2] = bflo(rc[j].y); v[j][3] = bfhi(rc[j].y); v[j][4] = bflo(rc[j].z); v[j][5] = bfhi(rc[j].z); v[j][6] = bflo(rc[j].w); v[j][7] = bfhi(rc[j].w);
            s += ((v[j][0] + v[j][1]) + (v[j][2] + v[j][3])) + ((v[j][4] + v[j][5]) + (v[j][6] + v[j][7])); }
        const float mean = wave_sum(s) * (1.f / D); float s2 = 0.f;
#pragma unroll
        for (int j = 0; j < 8; ++j)
#pragma unroll
            for (int e = 0; e < 8; ++e) { v[j][e] -= mean; s2 += v[j][e] * v[j][e]; }
        const float rstd = 1.f / sqrtf(wave_sum(s2) * (1.f / D) + LN_EPS);
        if (stats && lane == 0) { stats[2 * m] = mean; stats[2 * m + 1] = rstd; }
        int lo = lane; asm volatile("" : "+v"(lo));
#pragma unroll
        for (int j = 0; j < 8; ++j) { const f32x4 w0 = WL4[128 * j + 2 * lo], w1 = WL4[128 * j + 2 * lo + 1], b0 = BL4[128 * j + 2 * lo], b1 = BL4[128 * j + 2 * lo + 1];
            float y[8];
#pragma unroll
            for (int e = 0; e < 4; ++e) { y[e] = v[j][e] * rstd * w0[e] + b0[e]; y[4 + e] = v[j][4 + e] * rstd * w1[e] + b1[e]; }
            if (outF) { *(f32x4*)(outF + (size_t)m * D + 512 * j + 8 * lane) = (f32x4){y[0], y[1], y[2], y[3]}; *(f32x4*)(outF + (size_t)m * D + 512 * j + 8 * lane + 4) = (f32x4){y[4], y[5], y[6], y[7]}; }
            if (outB) { v4u o; o.x = pk2(y[0], y[1]); o.y = pk2(y[2], y[3]); o.z = pk2(y[4], y[5]); o.w = pk2(y[6], y[7]); *(v4u*)(outB + (size_t)m * D + 512 * j + 8 * lane) = o; } }
#pragma unroll
        for (int j = 0; j < 8; ++j) rc[j] = rn[j];
        m = mn;
    }
    __syncthreads();
}

__device__ __forceinline__ void unpack8(const v4u w, float (&v)[8]) { v[0] = bflo(w.x); v[1] = bfhi(w.x); v[2] = bflo(w.y); v[3] = bfhi(w.y); v[4] = bflo(w.z); v[5] = bfhi(w.z); v[6] = bflo(w.w); v[7] = bfhi(w.w); }
__device__ __forceinline__ v4u pack8(const float (&v)[8]) { v4u o; o.x = pk2(v[0], v[1]); o.y = pk2(v[2], v[3]); o.z = pk2(v[4], v[5]); o.w = pk2(v[6], v[7]); return o; }
__device__ __forceinline__ void norm_phase(const Args& A, Frame& F, int l) {
    const bool grp = (F.G == 256); const int lane = lane_now(); const int pbase = 256 * (8 * (int)(blockIdx.x & 7u) + (int)((blockIdx.x >> 3) & 7u));
    const int gw = grp ? pbase + ((int)(blockIdx.x >> 6) * NWAVES + F.wave) : F.vcu * NWAVES + F.wave, NGW = grp ? 32 : F.G * NWAVES, MEND = grp ? pbase + 256 : M;
    const bf16* za = (const bf16*)(A.ws + WS_ZA); const bf16* uz = (const bf16*)(A.ws + WS_UZ); const bf16* o = (const bf16*)(A.ws + WS_O);
    const bf16* proj = (const bf16*)(A.ws + WS_PROJ); bf16* cat = (bf16*)(A.ws + WS_CAT);
    const float* naw = A.in[I_NAW] + l * S5W; const float* nbw = A.in[I_NBW] + l * SGW; const float* hnw = A.in[I_HGNW] + l * 128;
    v4u ra[2], ru[2], ro[4], rg[4], na[2], nu[2], no[4], ng[4];
#define NORM_LOAD(m_, a_, u_, o_, g_) do { _Pragma("unroll") for (int j = 0; j < 2; ++j) { a_[j] = *(const v4u*)(za + (size_t)(m_) * S5W + 512 * j + 8 * lane); u_[j] = *(const v4u*)(uz + (size_t)(m_) * SGW + 512 * j + 8 * lane); } \
        _Pragma("unroll") for (int j = 0; j < 4; ++j) { o_[j] = *(const v4u*)(o + (size_t)(m_) * HGW + 512 * j + 8 * lane); g_[j] = *(const v4u*)(proj + (size_t)(m_) * PROJ + C_G + 512 * j + 8 * lane); } } while (0)
    int m = gw; if (m < MEND) NORM_LOAD(m, ra, ru, ro, rg);
    while (m < MEND) {
        const int mn = m + NGW; if (mn < MEND) NORM_LOAD(mn, na, nu, no, ng);
        int lo = lane; asm volatile("" : "+v"(lo));
#pragma unroll
        for (int part = 0; part < 2; ++part) {
            const float* wv = part ? nbw : naw;
            float v[2][8]; float ss = 0.f;
#pragma unroll
            for (int j = 0; j < 2; ++j) { unpack8(part ? ru[j] : ra[j], v[j]);
#pragma unroll
                for (int e = 0; e < 8; ++e) ss += v[j][e] * v[j][e]; }
            const float r = 1.f / sqrtf(wave_sum(ss) * (1.f / 1024.f) + RMS_EPS);
#pragma unroll
            for (int j = 0; j < 2; ++j) { const f32x4 w0 = *(const f32x4*)(wv + 512 * j + 8 * lo), w1 = *(const f32x4*)(wv + 512 * j + 8 * lo + 4);
                float y[8];
#pragma unroll
                for (int e = 0; e < 4; ++e) { y[e] = v[j][e] * r * w0[e]; y[4 + e] = v[j][4 + e] * r * w1[e]; }
                *(v4u*)(cat + (size_t)m * D + part * S5W + 512 * j + 8 * lane) = pack8(y); }
        }
        const f32x4 hw0 = *(const f32x4*)(hnw + 8 * (lo & 15)), hw1 = *(const f32x4*)(hnw + 8 * (lo & 15) + 4);
#pragma unroll
        for (int j = 0; j < 4; ++j) {
            float v[8], gv[8]; unpack8(ro[j], v); unpack8(rg[j], gv);
            float ss = 0.f;
#pragma unroll
            for (int e = 0; e < 8; ++e) ss += v[e] * v[e];
#pragma unroll
            for (int sh = 1; sh < 16; sh <<= 1) ss += __shfl_xor(ss, sh);
            const float r = 1.f / sqrtf(ss * (1.f / 128.f) + RMS_EPS);
            float y[8];
#pragma unroll
            for (int e = 0; e < 4; ++e) { y[e] = v[e] * r * hw0[e] * silu_f(gv[e]); y[4 + e] = v[4 + e] * r * hw1[e] * silu_f(gv[4 + e]); }
            *(v4u*)(cat + (size_t)m * D + S5W + SGW + 512 * j + 8 * lane) = pack8(y);
        }
#pragma unroll
        for (int j = 0; j < 2; ++j) { ra[j] = na[j]; ru[j] = nu[j]; }
#pragma unroll
        for (int j = 0; j < 4; ++j) { ro[j] = no[j]; rg[j] = ng[j]; }
        m = mn;
    }
#undef NORM_LOAD
}
__device__ __forceinline__ void sgu_stats_phase(const Args& A, int gw, int NGW, int lane) {
    const bf16* proj = (const bf16*)(A.ws + WS_PROJ); float* st = (float*)(A.ws + WS_STAT);
    v4u rc[2], rn[2]; int m = gw;
    if (m < M) { rc[0] = *(const v4u*)(proj + (size_t)m * PROJ + C_V + 8 * lane); rc[1] = *(const v4u*)(proj + (size_t)m * PROJ + C_V + 512 + 8 * lane); }
    while (m < M) {
        const int mn = m + NGW;
        if (mn < M) { rn[0] = *(const v4u*)(proj + (size_t)mn * PROJ + C_V + 8 * lane); rn[1] = *(const v4u*)(proj + (size_t)mn * PROJ + C_V + 512 + 8 * lane); }
        float v[16];
#pragma unroll
        for (int j = 0; j < 2; ++j) { const v4u w = rc[j];
            v[8 * j + 0] = gelu_f(bflo(w.x)); v[8 * j + 1] = gelu_f(bfhi(w.x)); v[8 * j + 2] = gelu_f(bflo(w.y)); v[8 * j + 3] = gelu_f(bfhi(w.y));
            v[8 * j + 4] = gelu_f(bflo(w.z)); v[8 * j + 5] = gelu_f(bfhi(w.z)); v[8 * j + 6] = gelu_f(bflo(w.w)); v[8 * j + 7] = gelu_f(bfhi(w.w)); }
        float s = 0.f;
#pragma unroll
        for (int j = 0; j < 16; ++j) s += v[j];
        const float mean = wave_sum(s) * (1.f / SGW); float s2 = 0.f;
#pragma unroll
        for (int j = 0; j < 16; ++j) { const float d = v[j] - mean; s2 += d * d; }
        const float rstd = 1.f / sqrtf(wave_sum(s2) * (1.f / SGW) + LN_EPS);
        if (lane == 0) { st[2 * m] = mean; st[2 * m + 1] = rstd; }
        rc[0] = rn[0]; rc[1] = rn[1]; m = mn;
    }
}
constexpr size_t HG_QT = 0, HG_KT = 64 * MiB, HG_KTT = 128 * MiB, HG_EM = 192 * MiB, HG_EE = 194 * MiB, HG_ER = 196 * MiB;
struct HgRaw { unsigned f[8], q[8]; };
__device__ __forceinline__ void hg_gate_load(const Args& A, int item, int lane, HgRaw& R) {
    const int kg = item & 7, tile = item >> 3, h = tile & 15, bc = tile >> 4; const int tseg = lane >> 3, kp = lane & 7, ch = h * 128 + kg * 16 + 2 * kp;
    const unsigned* p = (const unsigned*)((const bf16*)(A.ws + WS_PROJ) + ((size_t)bc * 64 + tseg * 8) * PROJ + ch);
#pragma unroll
    for (int i = 0; i < 8; ++i) { R.f[i] = p[(size_t)i * (PROJ / 2) + C_F / 2]; R.q[i] = p[(size_t)i * (PROJ / 2) + C_Q / 2]; }
}
__device__ __forceinline__ void hg_gate_compute(const Args& A, unsigned char* hgs, int l, int item, int lane, const HgRaw& R) {
    const int kg = item & 7, tile = item >> 3, h = tile & 15, bc = tile >> 4;
    const int tseg = lane >> 3, kp = lane & 7, ch = h * 128 + kg * 16 + 2 * kp;
    bf16* QT = (bf16*)(hgs + HG_QT); bf16* KT = (bf16*)(hgs + HG_KT);
    float* EM = (float*)(hgs + HG_EM); float* EE = (float*)(hgs + HG_EE); float* ER = (float*)(hgs + HG_ER);
    float lb[2] = {0.f, 0.f};
    if (l == 1) { lb[0] = sigmoid_f(A.in[I_HGLB][HGW + ch] - A.in[I_HGLB][ch]); lb[1] = sigmoid_f(A.in[I_HGLB][HGW + ch + 1] - A.in[I_HGLB][ch + 1]); }
    float bcum[2][8], kv[2][8], qv[2][8];
    float run[2] = {0.f, 0.f};
#pragma unroll
    for (int i = 0; i < 8; ++i)
#pragma unroll
        for (int c = 0; c < 2; ++c) {
            const float fr = fmaxf(c ? bfhi(R.f[i]) : bflo(R.f[i]), -80.f), qr = c ? bfhi(R.q[i]) : bflo(R.q[i]); const float omlb = 1.0f - lb[c];
            const float e = __builtin_amdgcn_exp2f(-1.4426950408889634f * fr), den = 1.0f + e, f0 = __builtin_amdgcn_rcpf(den);
            float lf;
            if (l == 0) lf = -__builtin_amdgcn_logf(den); else lf = __builtin_amdgcn_logf(lb[c] + omlb * f0);
            run[c] += lf; bcum[c][i] = run[c]; kv[c][i] = omlb * e * f0; qv[c][i] = qr * __builtin_amdgcn_rcpf(1.0f + __builtin_amdgcn_exp2f(-1.4426950408889634f * qr));
        }
    float bmid[2], bend[2], off[2];
#pragma unroll
    for (int c = 0; c < 2; ++c) { float pre = 0.f, mid = 0.f, tot = 0.f;
#pragma unroll
        for (int j = 0; j < 8; ++j) { const float tj = __shfl(run[c], kp + 8 * j); if (j < tseg) pre += tj; if (j < 4) mid += tj; tot += tj; }
        off[c] = pre; bmid[c] = mid; bend[c] = tot; }
    const size_t ti0 = ((size_t)tile * 64 + tseg * 8) * 128 + kg * 16 + 2 * kp;
#pragma unroll
    for (int i = 0; i < 8; ++i) {
        const float d0 = (off[0] + bcum[0][i]) - bmid[0], d1 = (off[1] + bcum[1][i]) - bmid[1];
        const unsigned qp = pk2(qv[0][i] * __builtin_amdgcn_exp2f(d0), qv[1][i] * __builtin_amdgcn_exp2f(d1)), kp2 = pk2(kv[0][i] * __builtin_amdgcn_exp2f(-d0), kv[1][i] * __builtin_amdgcn_exp2f(-d1));
        *(unsigned*)(QT + ti0 + (size_t)i * 128) = qp; *(unsigned*)(KT + ti0 + (size_t)i * 128) = kp2;
    }
    if (tseg == 0) { typedef float f32x2g __attribute__((ext_vector_type(2)));
        *(f32x2g*)(EM + (size_t)bc * HGW + ch) = (f32x2g){__builtin_amdgcn_exp2f(bmid[0]), __builtin_amdgcn_exp2f(bmid[1])};
        *(f32x2g*)(EE + (size_t)bc * HGW + ch) = (f32x2g){__builtin_amdgcn_exp2f(bend[0]), __builtin_amdgcn_exp2f(bend[1])};
        *(f32x2g*)(ER + (size_t)bc * HGW + ch) = (f32x2g){__builtin_amdgcn_exp2f(bend[0] - bmid[0]), __builtin_amdgcn_exp2f(bend[1] - bmid[1])}; }
}
__device__ __forceinline__ void hg_gate_phase(const Args& A, unsigned char* hgs, int l, int gw, int NGW, int lane) {
    constexpr int NIT = BATCH * 64 * 16 * 8;
    HgRaw R0, R1;
    int it = gw; if (it >= NIT) return;
    hg_gate_load(A, it, lane, R0);
    for (;;) {
        const int it1 = it + NGW; if (it1 < NIT) hg_gate_load(A, it1, lane, R1);
        hg_gate_compute(A, hgs, l, it, lane, R0);
        if (it1 >= NIT) break;
        const int it2 = it1 + NGW; if (it2 < NIT) hg_gate_load(A, it2, lane, R0);
        hg_gate_compute(A, hgs, l, it1, lane, R1);
        if (it2 >= NIT) break;
        it = it2;
    }
}
constexpr int HGL_EL = 98304, HGL_PL = 102912, HGL_STL = 112128;
typedef short hg_s4v __attribute__((ext_vector_type(4)));
#define HG_TR(dst, addr, off) asm volatile("ds_read_b64_tr_b16 %0, %1 offset:%2" : "=v"(dst) : "v"(addr), "n"(off))
struct HgCtx { const char* qt; const char* kt; const char* vp; const char* em; bf16* o; int b, h, vq; unsigned gq[2], gv, ge; };
__device__ __forceinline__ void hg_dma(const HgCtx& X, LAS unsigned char* L, LAS unsigned char* LV, int c, int bi, int w, int lane) {
    const size_t tile = ((size_t)X.b * 64 + c) * 16 + X.h; const char* q = X.qt + tile * 16384; const char* k = X.kt + tile * 16384;
    LAS unsigned char* Qb = L + bi * 32768 + w * 2048;
#pragma unroll
    for (int i = 0; i < 2; ++i) { __builtin_amdgcn_global_load_lds((const unsigned*)(q + X.gq[i]), (LAS unsigned*)(Qb + i * 1024), 16, 0, 0);
                                  __builtin_amdgcn_global_load_lds((const unsigned*)(k + X.gq[i]), (LAS unsigned*)(Qb + 16384 + i * 1024), 16, 0, 0); }
    if (lane < 32) __builtin_amdgcn_global_load_lds((const unsigned*)(X.vp + (size_t)c * (64 * PROJ * 2) + X.gv), (LAS unsigned*)(LV + bi * 4096 + w * 512), 16, 0, 0);
    if (lane < 48) __builtin_amdgcn_global_load_lds((const unsigned*)(X.em + (size_t)c * (HGW * 4) + X.ge), (LAS unsigned*)(L + HGL_EL + bi * 1536 + w * 192), 4, 0, 0);
}
__device__ __forceinline__ void hg_step(const HgCtx& X, LAS unsigned char* L, LAS unsigned char* LV, int c, int bi, int bi2, f32x4 (&S)[2], int w, int lane, int l15, int l4, const unsigned (&swz)[4], const unsigned (&tro)[2], unsigned vo) {
    asm volatile("s_waitcnt vmcnt(6)" ::: "memory");
    LDS_BARRIER();
    hg_dma(X, L, LV, (c + 2 < 64) ? c + 2 : 63, bi2, w, lane);
    LAS unsigned char* Qb = L + bi * 32768; LAS unsigned char* Kb = Qb + 16384; LAS unsigned char* Vb = LV + bi * 4096; LAS float* EL = (LAS float*)(L + HGL_EL + bi * 1536);
    LAS bf16* PL = (LAS bf16*)(L + HGL_PL); LAS bf16* STL = (LAS bf16*)(L + HGL_STL);
    const int tt = w >> 1, st0 = 2 * (w & 1);
    bf16x8 qf[4], kf[2][4], ktf[2], vf[2][2];
#pragma unroll
    for (int kb = 0; kb < 4; ++kb) qf[kb] = *(const LAS bf16x8*)(Qb + tt * 4096 + swz[kb]);
    const bool live0 = st0 <= tt, live1 = st0 + 1 <= tt;
#pragma unroll
    for (int kb = 0; kb < 4; ++kb) { kf[0][kb] = (bf16x8){0, 0, 0, 0, 0, 0, 0, 0}; kf[1][kb] = kf[0][kb]; }
    if (live0) {
#pragma unroll
        for (int kb = 0; kb < 4; ++kb) kf[0][kb] = *(const LAS bf16x8*)(Kb + st0 * 4096 + swz[kb]); }
    if (live1) {
#pragma unroll
        for (int kb = 0; kb < 4; ++kb) kf[1][kb] = *(const LAS bf16x8*)(Kb + (st0 + 1) * 4096 + swz[kb]); }
    hg_s4v tk[2][2], tv[2][2][2];
    { const unsigned ka = (unsigned)(unsigned long long)Kb, va_ = (unsigned)(unsigned long long)Vb + vo; const unsigned k0 = ka + tro[0], k1 = ka + tro[1];
      HG_TR(tk[0][0], k0, 0); HG_TR(tk[0][1], k1, 0); HG_TR(tk[1][0], k0, 8192); HG_TR(tk[1][1], k1, 8192);
      HG_TR(tv[0][0][0], va_, 0); HG_TR(tv[0][0][1], va_, 256); HG_TR(tv[1][0][0], va_, 32); HG_TR(tv[1][0][1], va_, 288);
      HG_TR(tv[0][1][0], va_, 2048); HG_TR(tv[0][1][1], va_, 2304); HG_TR(tv[1][1][0], va_, 2080); HG_TR(tv[1][1][1], va_, 2336); }
    const f32x4 em = *(const LAS f32x4*)(EL + w * 16 + 4 * l4), ee = *(const LAS f32x4*)(EL + 128 + w * 16 + 4 * l4), er = *(const LAS f32x4*)(EL + 256 + w * 16 + 4 * l4);
    asm volatile("s_waitcnt lgkmcnt(0)" : "+v"(tk[0][0]), "+v"(tk[0][1]), "+v"(tk[1][0]), "+v"(tk[1][1]), "+v"(tv[0][0][0]), "+v"(tv[0][0][1]), "+v"(tv[1][0][0]), "+v"(tv[1][0][1]),
                 "+v"(tv[0][1][0]), "+v"(tv[0][1][1]), "+v"(tv[1][1][0]), "+v"(tv[1][1][1]) : : "memory"); __builtin_amdgcn_sched_barrier(0);
#pragma unroll
    for (int sb = 0; sb < 2; ++sb) { ktf[sb] = (bf16x8){tk[sb][0][0], tk[sb][0][1], tk[sb][0][2], tk[sb][0][3], tk[sb][1][0], tk[sb][1][1], tk[sb][1][2], tk[sb][1][3]};
#pragma unroll
        for (int vt = 0; vt < 2; ++vt) vf[vt][sb] = (bf16x8){tv[vt][sb][0][0], tv[vt][sb][0][1], tv[vt][sb][0][2], tv[vt][sb][0][3], tv[vt][sb][1][0], tv[vt][sb][1][1], tv[vt][sb][1][2], tv[vt][sb][1][3]}; }
    f32x4 pa[2], dS[2];
    pa[0] = (f32x4){0.f, 0.f, 0.f, 0.f}; pa[1] = pa[0]; dS[0] = pa[0]; dS[1] = pa[0];
#pragma unroll
    for (int kb = 0; kb < 4; ++kb) {
        if (live0) pa[0] = __builtin_amdgcn_mfma_f32_16x16x32_bf16(kf[0][kb], qf[kb], pa[0], 0, 0, 0);
        if (live1) pa[1] = __builtin_amdgcn_mfma_f32_16x16x32_bf16(kf[1][kb], qf[kb], pa[1], 0, 0, 0);
        if (kb < 2) {
#pragma unroll
            for (int vt = 0; vt < 2; ++vt) dS[vt] = __builtin_amdgcn_mfma_f32_16x16x32_bf16(ktf[kb], vf[vt][kb], dS[vt], 0, 0, 0); }
    }
#pragma unroll
    for (int j = 0; j < 2; ++j) { const int st = st0 + j; f32x4 acc = pa[j];
        if (st > tt) acc = (f32x4){0.f, 0.f, 0.f, 0.f};
        if (st == tt) {
#pragma unroll
            for (int r = 0; r < 4; ++r) if (4 * l4 + r > l15) acc[r] = 0.f; }
        *(LAS unsigned long long*)(PL + (tt * 16 + l15) * 72 + st * 16 + 4 * l4) = (unsigned long long)pk2(acc[0], acc[1]) | ((unsigned long long)pk2(acc[2], acc[3]) << 32); }
#pragma unroll
    for (int vt = 0; vt < 2; ++vt) { const f32x4 sv = S[vt] * em;
        *(LAS unsigned long long*)(STL + (vt * 16 + l15) * 136 + w * 16 + 4 * l4) = (unsigned long long)pk2(sv[0], sv[1]) | ((unsigned long long)pk2(sv[2], sv[3]) << 32); }
    LDS_BARRIER();
    {   const int vt = w & 1;
        bf16x8 va[2], pb[2], sa[4];
#pragma unroll
        for (int sb = 0; sb < 2; ++sb) pb[sb] = *(const LAS bf16x8*)(PL + (tt * 16 + l15) * 72 + sb * 32 + 8 * l4);
        hg_s4v ta[2][2];
        { const unsigned va_ = (unsigned)(unsigned long long)Vb + vo + (unsigned)(vt * 32); HG_TR(ta[0][0], va_, 0); HG_TR(ta[0][1], va_, 256); HG_TR(ta[1][0], va_, 2048); HG_TR(ta[1][1], va_, 2304); }
#pragma unroll
        for (int kb = 0; kb < 4; ++kb) sa[kb] = *(const LAS bf16x8*)(STL + (vt * 16 + l15) * 136 + kb * 32 + 8 * l4);
        asm volatile("s_waitcnt lgkmcnt(0)" : "+v"(ta[0][0]), "+v"(ta[0][1]), "+v"(ta[1][0]), "+v"(ta[1][1]) : : "memory"); __builtin_amdgcn_sched_barrier(0);
#pragma unroll
        for (int sb = 0; sb < 2; ++sb) va[sb] = (bf16x8){ta[sb][0][0], ta[sb][0][1], ta[sb][0][2], ta[sb][0][3], ta[sb][1][0], ta[sb][1][1], ta[sb][1][2], ta[sb][1][3]};
        f32x4 a0 = (f32x4){0.f, 0.f, 0.f, 0.f}, a1 = a0;
#pragma unroll
        for (int sb = 0; sb < 2; ++sb) a0 = __builtin_amdgcn_mfma_f32_16x16x32_bf16(va[sb], pb[sb], a0, 0, 0, 0);
#pragma unroll
        for (int kb = 0; kb < 4; ++kb) { if (kb & 1) a0 = __builtin_amdgcn_mfma_f32_16x16x32_bf16(sa[kb], qf[kb], a0, 0, 0, 0); else a1 = __builtin_amdgcn_mfma_f32_16x16x32_bf16(sa[kb], qf[kb], a1, 0, 0, 0); }
        const f32x4 acc = a0 + a1;
        *(unsigned long long*)(X.o + (((size_t)X.b * 64 + c) * 64 + tt * 16 + l15) * HGW + X.h * 128 + X.vq * 32 + vt * 16 + 4 * l4) = (unsigned long long)pk2(acc[0], acc[1]) | ((unsigned long long)pk2(acc[2], acc[3]) << 32);
    }
#pragma unroll
    for (int vt = 0; vt < 2; ++vt) S[vt] = ee * S[vt] + er * dS[vt];
}
__device__ __forceinline__ void hg_chunk_item(const Args& A, Frame& F, const unsigned char* hgs, int item) {
    const int tid = tid_now(F), lane = tid & 63, w = F.wave, l15 = lane & 15, l4 = lane >> 4;
    LAS unsigned char* L = F.lds + RING_OFF; LAS unsigned char* LV = F.lds + STATL_OFF;
    HgCtx X; X.b = item >> 6; X.h = (item >> 2) & 15; X.vq = item & 3; X.o = (bf16*)(A.ws + WS_O);
    X.qt = (const char*)(hgs + HG_QT); X.kt = (const char*)(hgs + HG_KT);
    X.vp = (const char*)((const bf16*)(A.ws + WS_PROJ) + ((size_t)X.b * 64 * 64) * PROJ + C_I + X.h * 128 + X.vq * 32);
    X.em = (const char*)((const float*)(hgs + HG_EM) + ((size_t)X.b * 64) * HGW + X.h * 128);
#pragma unroll
    for (int i = 0; i < 2; ++i) { const int r = 4 * (2 * w + i) + (lane >> 4), cs = lane & 15; X.gq[i] = (unsigned)((r * 128 + ((cs ^ (r & 15)) * 8)) * 2); }
    X.gv = (unsigned)(((8 * w + (lane >> 2)) * PROJ + (lane & 3) * 8) * 2);
    { const int f = 48 * w + (lane < 48 ? lane : 0); X.ge = (unsigned)((f >> 7) * (2 * MiB) + (f & 127) * 4); }
    unsigned swz[4], tro[2];
#pragma unroll
    for (int kb = 0; kb < 4; ++kb) swz[kb] = (unsigned)(l15 * 256 + (((kb * 4 + l4) ^ l15) << 4));
#pragma unroll
    for (int hh = 0; hh < 2; ++hh) { const int sl = 8 * l4 + (l15 >> 2) + 4 * hh; tro[hh] = (unsigned)(sl * 256 + (((2 * w + ((l15 & 3) >> 1)) ^ (sl & 15)) << 4) + (l15 & 1) * 8); }
    const unsigned vo = (unsigned)((8 * l4 + (l15 >> 2)) * 64 + 8 * (l15 & 3));
    f32x4 S[2]; S[0] = (f32x4){0.f, 0.f, 0.f, 0.f}; S[1] = S[0];
    __syncthreads();
    hg_dma(X, L, LV, 0, 0, w, lane); hg_dma(X, L, LV, 1, 1, w, lane);
    int bi = 0, bi2 = 2;
#pragma unroll 1
    for (int c = 0; c < 64; ++c) { hg_step(X, L, LV, c, bi, bi2, S, w, lane, l15, l4, swz, tro, vo); bi = (bi == 2) ? 0 : bi + 1; bi2 = (bi2 == 2) ? 0 : bi2 + 1; }
    asm volatile("s_waitcnt vmcnt(0)" ::: "memory");
    __syncthreads();
}
constexpr size_t WS_S5M = WS_STAT + 1 * MiB, S5M_STRIDE = 262144, S5M_KM = 0, S5M_CI = 131072, S5M_BO = 196608;
constexpr size_t WS_XV = WS_S5M + 32 * MiB;
constexpr size_t WS_XH = WS_XV + 32 * MiB;
constexpr size_t WS_XL = WS_XH + 16 * MiB;
constexpr size_t WS_CVP = WS_XL + 16 * MiB;
constexpr size_t WS_MID = WS_CVP + 40 * MiB;
constexpr size_t WS_END2 = WS_MID + 344 * MiB;
static_assert(WS_CVP == WS_CVP_, "partial column-sum buffer offset");
__device__ __forceinline__ void s5_build_item(const Args& A, Frame& F, int item) {
    const int l = item >> 6, g = item & 63; const int tid = tid_now(F);
    LAS float* pw = (LAS float*)(F.lds + RING_OFF);
    LAS float* bb = pw + 17 * 64 * 2;
    LAS float* cc = bb + 64 * 16 * 2;
    LAS float* kt = cc + 16 * 64 * 2;
    if (tid < 64) { const int n = tid;
        const float lr = fminf(A.in[I_LAMRE][(l * 64 + g) * 64 + n], -1e-4f), li = A.in[I_LAMIM][(l * 64 + g) * 64 + n];
        const float dt = expf(A.in[I_LOGSTEP][l * 64 + g]);
        for (int t = 0; t <= 16; ++t) { const float mg = expf((float)t * lr * dt); float sn, cs; sincosf((float)t * li * dt, &sn, &cs); pw[(t * 64 + n) * 2] = mg * cs; pw[(t * 64 + n) * 2 + 1] = mg * sn; }
        const float mag = expf(lr * dt), ab_re = mag * cosf(li * dt), ab_im = mag * sinf(li * dt);
        const float den = lr * lr + li * li, nr = ab_re - 1.0f;
        const float g_re = (nr * lr + ab_im * li) / den, g_im = (ab_im * lr - nr * li) / den;
        for (int c = 0; c < 16; ++c) { const float br = A.in[I_BRE][((size_t)(l * 64 + g) * 64 + n) * 16 + c], bi = A.in[I_BIM][((size_t)(l * 64 + g) * 64 + n) * 16 + c];
            bb[(n * 16 + c) * 2] = g_re * br - g_im * bi; bb[(n * 16 + c) * 2 + 1] = g_re * bi + g_im * br;
            cc[(c * 64 + n) * 2] = A.in[I_CRE][((size_t)(l * 64 + g) * 16 + c) * 64 + n]; cc[(c * 64 + n) * 2 + 1] = A.in[I_CIM][((size_t)(l * 64 + g) * 16 + c) * 64 + n]; }
    }
    __syncthreads();
    for (int q = 0; q < 8; ++q) { const int idx = tid + 512 * q, t = idx >> 8, c = (idx >> 4) & 15, cp = idx & 15; float acc = 0.f;
        for (int n = 0; n < 64; ++n) { const float pr = pw[(t * 64 + n) * 2], pi = pw[(t * 64 + n) * 2 + 1], br = bb[(n * 16 + cp) * 2], bi = bb[(n * 16 + cp) * 2 + 1], cr = cc[(c * 64 + n) * 2], ci = cc[(c * 64 + n) * 2 + 1];
            const float wr = pr * br - pi * bi, wi = pr * bi + pi * br; acc += cr * wr - ci * wi; }
        kt[idx] = acc; }
    __syncthreads();
    unsigned char* base = A.ws + WS_S5M + (size_t)item * S5M_STRIDE;
    bf16* KM = (bf16*)(base + S5M_KM); bf16* CI = (bf16*)(base + S5M_CI); bf16* BO = (bf16*)(base + S5M_BO);
    for (int q = 0; q < 2; ++q) { const int v = tid + 512 * q, row = v >> 2, colv = v & 3, j = colv >> 1, c0 = (colv & 1) * 8, i = row >> 4, c = row & 15; float val[8];
#pragma unroll
        for (int e = 0; e < 8; ++e) { float x = (i >= j) ? kt[((i - j) * 16 + c) * 16 + c0 + e] : 0.f; if (i == j && c == c0 + e) x += A.in[I_S5D][l * S5W + g * 16 + c]; val[e] = x; }
        v4u o; o.x = pk2(val[0], val[1]); o.y = pk2(val[2], val[3]); o.z = pk2(val[4], val[5]); o.w = pk2(val[6], val[7]); *(v4u*)(KM + (size_t)row * 256 + colv * 8) = o; }
    for (int q = 0; q < 8; ++q) { const int v = tid + 512 * q, row = v >> 4, m0 = (v & 15) * 8, i = row >> 4, c = row & 15; float val[8];
#pragma unroll
        for (int e = 0; e < 8; ++e) { const int m = m0 + e, n = m & 63; const float pr = pw[((i + 1) * 64 + n) * 2], pi = pw[((i + 1) * 64 + n) * 2 + 1], cr = cc[(c * 64 + n) * 2], ci = cc[(c * 64 + n) * 2 + 1];
            val[e] = (m >= 64) ? -(cr * pi + ci * pr) : (cr * pr - ci * pi); }
        v4u o; o.x = pk2(val[0], val[1]); o.y = pk2(val[2], val[3]); o.z = pk2(val[4], val[5]); o.w = pk2(val[6], val[7]); *(v4u*)(CI + (size_t)row * 128 + m0) = o; }
    for (int q = 0; q < 8; ++q) { const int v = tid + 512 * q, m = v >> 5, colv = v & 31, j = colv >> 1, c0 = (colv & 1) * 8, n = m & 63; float val[8];
        const float pr = pw[((15 - j) * 64 + n) * 2], pi = pw[((15 - j) * 64 + n) * 2 + 1];
#pragma unroll
        for (int e = 0; e < 8; ++e) { const float br = bb[(n * 16 + c0 + e) * 2], bi = bb[(n * 16 + c0 + e) * 2 + 1]; val[e] = (m >= 64) ? (pr * bi + pi * br) : (pr * br - pi * bi); }
        v4u o; o.x = pk2(val[0], val[1]); o.y = pk2(val[2], val[3]); o.z = pk2(val[4], val[5]); o.w = pk2(val[6], val[7]); *(v4u*)(BO + (size_t)m * 256 + colv * 8) = o; }
    __syncthreads();
}
__device__ __forceinline__ const char* s5_ubase(const bf16* proj, int r0, int g, int kb) { const int b = r0 >> 8, ck = r0 & 255; return (const char*)(proj + ((size_t)b * SEQ + ck * 16 + 2 * kb) * PROJ + C_XA + g * 16); }
struct S5VFrag { bf16x8 u[2]; bf16x8 w[8]; };
__device__ __forceinline__ void s5_v_item(const Args& A, int l, int rb, int g, int lane) {
    const int l15 = lane & 15, l4 = lane >> 4;
    const bf16* proj = (const bf16*)(A.ws + WS_PROJ); const char* BO = (const char*)(A.ws + WS_S5M + (size_t)(l * 64 + g) * S5M_STRIDE + S5M_BO);
    float* XV = (float*)(A.ws + WS_XV);
    const unsigned uoff = (unsigned)((l15 * 16 + (l4 >> 1)) * PROJ * 2 + 16 * (l4 & 1)), boff = (unsigned)(l15 * 512 + l4 * 16);
    f32x4 acc[2][8];
#pragma unroll
    for (int mt = 0; mt < 2; ++mt)
#pragma unroll
        for (int nt = 0; nt < 8; ++nt) acc[mt][nt] = (f32x4){0.f, 0.f, 0.f, 0.f};
#define S5V_LOAD(F_, kb_) do { _Pragma("unroll") for (int mt = 0; mt < 2; ++mt) F_.u[mt] = *(const bf16x8*)(s5_ubase(proj, rb * 32 + mt * 16, g, (kb_)) + uoff); \
        _Pragma("unroll") for (int nt = 0; nt < 8; ++nt) F_.w[nt] = *(const bf16x8*)(BO + (nt * 16 * 512 + (kb_) * 64) + boff); } while (0)
#define S5V_MMA(F_) do { _Pragma("unroll") for (int nt = 0; nt < 8; ++nt) { _Pragma("unroll") for (int mt = 0; mt < 2; ++mt) acc[mt][nt] = __builtin_amdgcn_mfma_f32_16x16x32_bf16(F_.w[nt], F_.u[mt], acc[mt][nt], 0, 0, 0); } } while (0)
    S5VFrag F0, F1;
    S5V_LOAD(F0, 0);
#pragma unroll
    for (int kb = 0; kb < 8; kb += 2) { S5V_LOAD(F1, kb + 1); S5V_MMA(F0); if (kb + 2 < 8) S5V_LOAD(F0, kb + 2); S5V_MMA(F1); }
#undef S5V_LOAD
#undef S5V_MMA
    char* xvb = (char*)(XV + ((size_t)g * 1024 + rb * 32) * 128); const unsigned xoff = (unsigned)(l15 * 512 + l4 * 16);
#pragma unroll
    for (int mt = 0; mt < 2; ++mt)
#pragma unroll
        for (int nt = 0; nt < 8; ++nt) *(f32x4*)(xvb + (mt * 16 * 512 + nt * 64) + xoff) = acc[mt][nt];
}
__device__ __forceinline__ void s5_scan_wg(const Args& A, Frame& F, int l, int item, int lane) {
    const int g = item >> 2, b = item & 3, n = lane, w = F.wave;
    const float lr = fminf(A.in[I_LAMRE][(l * 64 + g) * 64 + n], -1e-4f), li = A.in[I_LAMIM][(l * 64 + g) * 64 + n];
    const float dt = expf(A.in[I_LOGSTEP][l * 64 + g]);
    const float mg = expf(16.f * lr * dt); float sn, cs; sincosf(16.f * li * dt, &sn, &cs);
    const float ar = mg * cs, ai = mg * sn;
    float br = ar, bi = ai;
#pragma unroll
    for (int q = 0; q < 5; ++q) { const float tr = br * br - bi * bi, ti = 2.f * br * bi; br = tr; bi = ti; }
    const float* XV = (const float*)(A.ws + WS_XV) + ((size_t)g * 1024 + b * 256 + 32 * w) * 128;
    bf16* XH = (bf16*)(A.ws + WS_XH) + ((size_t)g * 1024 + b * 256 + 32 * w) * 128; bf16* XL = (bf16*)(A.ws + WS_XL) + ((size_t)g * 1024 + b * 256 + 32 * w) * 128;
    LAS float* EX = (LAS float*)(F.lds + RING_OFF);
    float vr[32], vi[32];
#pragma unroll
    for (int k = 0; k < 32; ++k) { vr[k] = XV[k * 128 + n]; vi[k] = XV[k * 128 + 64 + n]; }
    float xr = 0.f, xi = 0.f;
#pragma unroll
    for (int k = 0; k < 32; ++k) { const float pr = xr, pi = xi; const float tr = ar * xr - ai * xi + vr[k], ti = ar * xi + ai * xr + vi[k]; xr = tr; xi = ti; vr[k] = pr; vi[k] = pi; }
    EX[(w * 64 + n) * 2] = xr; EX[(w * 64 + n) * 2 + 1] = xi;
    __syncthreads();
    float sr = 0.f, si = 0.f;
    for (int q = 0; q < w; ++q) { const float er = EX[(q * 64 + n) * 2], ei = EX[(q * 64 + n) * 2 + 1]; const float tr = br * sr - bi * si + er, ti = br * si + bi * sr + ei; sr = tr; si = ti; }
#pragma unroll
    for (int k = 0; k < 32; ++k) {
        const float pr = vr[k] + sr, pi = vi[k] + si;
        const unsigned hp = pk2(pr, pi); const float hr = __uint_as_float(hp << 16), hi = __uint_as_float(hp & 0xffff0000u); const unsigned lp = pk2(pr - hr, pi - hi);
        XH[k * 128 + n] = (bf16)(hp & 0xffffu); XH[k * 128 + 64 + n] = (bf16)(hp >> 16);
        XL[k * 128 + n] = (bf16)(lp & 0xffffu); XL[k * 128 + 64 + n] = (bf16)(lp >> 16);
        const float tr = ar * sr - ai * si, ti = ar * si + ai * sr; sr = tr; si = ti;
    }
    __syncthreads();
}
__device__ __forceinline__ void s5_y_item(const Args& A, int l, int rb, int g, int lane) {
    const int l15 = lane & 15, l4 = lane >> 4;
    const bf16* proj = (const bf16*)(A.ws + WS_PROJ);
    const char* KM = (const char*)(A.ws + WS_S5M + (size_t)(l * 64 + g) * S5M_STRIDE + S5M_KM); const char* CI = (const char*)(A.ws + WS_S5M + (size_t)(l * 64 + g) * S5M_STRIDE + S5M_CI);
    const char* XH = (const char*)(A.ws + WS_XH) + ((size_t)g * 1024 + rb * 32) * 256; const char* XL = (const char*)(A.ws + WS_XL) + ((size_t)g * 1024 + rb * 32) * 256;
    const unsigned uoff = (unsigned)((l15 * 16 + (l4 >> 1)) * PROJ * 2 + 16 * (l4 & 1)), koff = (unsigned)(l15 * 512 + l4 * 16), coff = (unsigned)(l15 * 256 + l4 * 16);
    bf16* Z = (bf16*)(A.ws + WS_Z);
#pragma unroll
    for (int hf = 0; hf < 2; ++hf) {
        f32x4 acc[2][8]; bf16x8 kmf[16];
#pragma unroll
        for (int mt = 0; mt < 2; ++mt)
#pragma unroll
            for (int n8 = 0; n8 < 8; ++n8) acc[mt][n8] = (f32x4){0.f, 0.f, 0.f, 0.f};
#pragma unroll
        for (int kb = 0; kb < 8; ++kb) if (2 * kb <= 8 * hf + 7) {
            bf16x8 u[2];
#pragma unroll
            for (int mt = 0; mt < 2; ++mt) u[mt] = *(const bf16x8*)(s5_ubase(proj, rb * 32 + mt * 16, g, kb) + uoff);
            if (kb == 0) {
#pragma unroll
                for (int d = 8 * hf; d < 8 * hf + 8; ++d) kmf[d] = *(const bf16x8*)(KM + (d * 16 * 512) + koff); }
            else {
#pragma unroll
                for (int e = 0; e < 2; ++e) { const int d = 8 * hf - 2 * kb + e; if (d >= 0) kmf[d] = *(const bf16x8*)(KM + (d * 16 * 512) + koff); } }
#pragma unroll
            for (int n8 = 0; n8 < 8; ++n8) { const int nt = 8 * hf + n8; if (2 * kb <= nt) {
#pragma unroll
                for (int mt = 0; mt < 2; ++mt) acc[mt][n8] = __builtin_amdgcn_mfma_f32_16x16x32_bf16(kmf[nt - 2 * kb], u[mt], acc[mt][n8], 0, 0, 0); } }
            asm volatile("" ::: "memory");
        }
#pragma unroll
        for (int kb = 0; kb < 4; ++kb) {
            bf16x8 xh[2], xl[2];
#pragma unroll
            for (int mt = 0; mt < 2; ++mt) { xh[mt] = *(const bf16x8*)(XH + (mt * 16 * 256 + kb * 64) + coff); xl[mt] = *(const bf16x8*)(XL + (mt * 16 * 256 + kb * 64) + coff); }
#pragma unroll
            for (int n8 = 0; n8 < 8; ++n8) { const int nt = 8 * hf + n8; const bf16x8 ci = *(const bf16x8*)(CI + (nt * 16 * 256 + kb * 64) + coff);
#pragma unroll
                for (int mt = 0; mt < 2; ++mt) { acc[mt][n8] = __builtin_amdgcn_mfma_f32_16x16x32_bf16(ci, xh[mt], acc[mt][n8], 0, 0, 0); acc[mt][n8] = __builtin_amdgcn_mfma_f32_16x16x32_bf16(ci, xl[mt], acc[mt][n8], 0, 0, 0); } }
            asm volatile("" ::: "memory");
        }
#pragma unroll
        for (int mt = 0; mt < 2; ++mt) { const int r0 = rb * 32 + mt * 16, b = r0 >> 8, ck = r0 & 255;
            char* zb = (char*)(Z + ((size_t)b * SEQ + ck * 16) * S5W + g * 16); const unsigned zoff = (unsigned)(l15 * 16 * S5W * 2 + l4 * 8);
#pragma unroll
            for (int n8 = 0; n8 < 8; ++n8) { const int nt = 8 * hf + n8; const f32x4 y = acc[mt][n8];
                *(unsigned long long*)(zb + nt * S5W * 2 + zoff) = (unsigned long long)pk2(gelu_f(y[0]), gelu_f(y[1])) | ((unsigned long long)pk2(gelu_f(y[2]), gelu_f(y[3])) << 32); } }
    }
}
__device__ __forceinline__ void sgu_phase(const Args& A, Frame& F, int l) {
    const int tid = tid_now(F), lane = tid & 63, w = F.wave, l15 = lane & 15, l4 = lane >> 4;
    const bf16* proj = (const bf16*)(A.ws + WS_PROJ); const float* st = (const float*)(A.ws + WS_CTL + CTL_SGST) + (size_t)l * 2 * M;   bf16* uz = (bf16*)(A.ws + WS_UZ);
    LAS bf16* VNT = (LAS bf16*)(F.lds + RING_OFF); LAS bf16* WL = (LAS bf16*)(F.lds + RING_OFF + 34816); LAS float* SL = (LAS float*)(F.lds + RING_OFF + 69632);
    typedef float f32x2s __attribute__((ext_vector_type(2)));
    constexpr int NIT = (M / 128) * 8;
    const int dp = tid & 63, sseg = tid >> 6;
    unsigned rv[16]; f32x4 rw[8]; f32x2s rs = {0.f, 0.f}; unsigned long long ru[8]; float rb = 0.f; f32x2s lw = {0.f, 0.f}, lbias = {0.f, 0.f};
#define SGU_LOAD_A(it_) do { const int ch_ = (it_) >> 3, h_ = (it_) & 7; const size_t cs_ = (size_t)ch_ * 128; \
        const unsigned* pv_ = (const unsigned*)(proj + (cs_ + sseg * 16) * PROJ + C_V + h_ * 128 + 2 * dp); \
        _Pragma("unroll") for (int i = 0; i < 16; ++i) rv[i] = pv_[(size_t)i * (PROJ / 2)]; \
        const float* Wg_ = A.in[I_SGW] + ((size_t)(l * 8 + h_) * 128) * 128; \
        _Pragma("unroll") for (int q = 0; q < 4; ++q) { const int v_ = tid + 512 * q; rw[2 * q] = *(const f32x4*)(Wg_ + v_ * 8); rw[2 * q + 1] = *(const f32x4*)(Wg_ + v_ * 8 + 4); } \
        if (tid < 128) rs = *(const f32x2s*)(st + 2 * (cs_ + tid)); \
        lw = *(const f32x2s*)(A.in[I_SGLNW] + l * SGW + h_ * 128 + 2 * dp); lbias = *(const f32x2s*)(A.in[I_SGLNB] + l * SGW + h_ * 128 + 2 * dp); } while (0)
#define SGU_LOAD_B(it_) do { const int ch_ = (it_) >> 3, h_ = (it_) & 7; const size_t row_ = (size_t)ch_ * 128 + w * 16 + l15; \
        _Pragma("unroll") for (int dt = 0; dt < 8; ++dt) ru[dt] = *(const unsigned long long*)(proj + row_ * PROJ + C_U + h_ * 128 + dt * 16 + 4 * l4); \
        rb = A.in[I_SGB][(l * 8 + h_) * 128 + w * 16 + l15]; } while (0)
    int it = F.vcu; if (it >= NIT) return;
    SGU_LOAD_A(it); SGU_LOAD_B(it);
    for (;;) {
        const int nit = it + F.G; const int ch = it >> 3, h = it & 7;
        if (tid < 128) { const float mean_ = rs[0] * (1.f / SGW), var_ = fmaxf(rs[1] * (1.f / SGW) - mean_ * mean_, 0.f); *(LAS f32x2s*)(SL + 2 * tid) = (f32x2s){mean_, 1.f / sqrtf(var_ + LN_EPS)}; }
        LDS_BARRIER();
#pragma unroll
        for (int q = 0; q < 2; ++q) { float y0[8], y1[8];
#pragma unroll
            for (int e = 0; e < 8; ++e) { const int s = sseg * 16 + q * 8 + e; const f32x2s ms = *(const LAS f32x2s*)(SL + 2 * s); const unsigned wv = rv[q * 8 + e];
                y0[e] = (gelu_f(bflo(wv)) - ms[0]) * ms[1] * lw[0] + lbias[0]; y1[e] = (gelu_f(bfhi(wv)) - ms[0]) * ms[1] * lw[1] + lbias[1]; }
            v4u o; o.x = pk2(y0[0], y0[1]); o.y = pk2(y0[2], y0[3]); o.z = pk2(y0[4], y0[5]); o.w = pk2(y0[6], y0[7]); *(LAS v4u*)(VNT + (2 * dp) * 136 + sseg * 16 + q * 8) = o;
            v4u p; p.x = pk2(y1[0], y1[1]); p.y = pk2(y1[2], y1[3]); p.z = pk2(y1[4], y1[5]); p.w = pk2(y1[6], y1[7]); *(LAS v4u*)(VNT + (2 * dp + 1) * 136 + sseg * 16 + q * 8) = p; }
#pragma unroll
        for (int q = 0; q < 4; ++q) { const int v = tid + 512 * q, t = v >> 4, s0 = (v & 15) * 8; const f32x4 a = rw[2 * q], b = rw[2 * q + 1];
            v4u o; o.x = pk2(s0 + 0 <= t ? a[0] : 0.f, s0 + 1 <= t ? a[1] : 0.f); o.y = pk2(s0 + 2 <= t ? a[2] : 0.f, s0 + 3 <= t ? a[3] : 0.f);
            o.z = pk2(s0 + 4 <= t ? b[0] : 0.f, s0 + 5 <= t ? b[1] : 0.f); o.w = pk2(s0 + 6 <= t ? b[2] : 0.f, s0 + 7 <= t ? b[3] : 0.f);
            *(LAS v4u*)(WL + t * 136 + s0) = o; }
        if (nit < NIT) SGU_LOAD_A(nit);
        LDS_BARRIER();
        f32x4 acc[8];
#pragma unroll
        for (int dt = 0; dt < 8; ++dt) acc[dt] = (f32x4){0.f, 0.f, 0.f, 0.f};
        const int nkb = (w >> 1) + 1;
        for (int kb = 0; kb < nkb; ++kb) {
            const bf16x8 wb = *(const LAS bf16x8*)(WL + (w * 16 + l15) * 136 + kb * 32 + 8 * l4);
#pragma unroll
            for (int dt = 0; dt < 8; ++dt) { const bf16x8 va = *(const LAS bf16x8*)(VNT + (dt * 16 + l15) * 136 + kb * 32 + 8 * l4);
                acc[dt] = __builtin_amdgcn_mfma_f32_16x16x32_bf16(va, wb, acc[dt], 0, 0, 0); }
        }
        {   const size_t row = (size_t)ch * 128 + w * 16 + l15;
#pragma unroll
            for (int dt = 0; dt < 8; ++dt) { const unsigned long long uw = ru[dt];
                const float o0 = gelu_f(bflo((unsigned)uw)) * (acc[dt][0] + rb), o1 = gelu_f(bfhi((unsigned)uw)) * (acc[dt][1] + rb), o2 = gelu_f(bflo((unsigned)(uw >> 32))) * (acc[dt][2] + rb), o3 = gelu_f(bfhi((unsigned)(uw >> 32))) * (acc[dt][3] + rb);
                *(unsigned long long*)(uz + row * SGW + h * 128 + dt * 16 + 4 * l4) = (unsigned long long)pk2(o0, o1) | ((unsigned long long)pk2(o2, o3) << 32); }
        }
        if (nit >= NIT) break;
        SGU_LOAD_B(nit);
        it = nit;
    }
    __syncthreads();
#undef SGU_LOAD_A
#undef SGU_LOAD_B
}
constexpr int PH_PER_LAYER = 10, N_PHASES = 2 + DEPTH * PH_PER_LAYER;
#ifndef PROBE_REP
#define PROBE_REP 0
#endif
#define REPC(c) _Pragma("unroll 1") for (int rep_ = 0, rep_n_ = (((PROBE_REP >> (c)) & 1) ? ((int)(args.rep >> (4 * (c))) & 15) : 1); rep_ < rep_n_; ++rep_)
#ifndef MK_ONE_LAUNCH
#define MK_ONE_LAUNCH 1
#endif
__global__ void __launch_bounds__(NWAVES * 64, 2) mega_fwd(KArgs kargs) {
    extern __shared__ __attribute__((aligned(16))) unsigned char lds[];
    Frame F;
    F.lds = (LAS unsigned char*)lds;
    F.wave = __builtin_amdgcn_readfirstlane((int)threadIdx.x >> 6);
    F.G = gridDim.x; { const int bx = blockIdx.x; F.vcu = (F.G % 8 == 0) ? (bx % 8) * (F.G / 8) + bx / 8 : bx; }
    Args args; args.in.t = (LAS const unsigned*)(F.lds + ARGTAB_OFF); args.out = kargs.out; args.ws = kargs.ws; args.rep = kargs.rep; args.ph_lo = kargs.ph_lo; args.ph_hi = kargs.ph_hi;
    unsigned char* ws = args.ws;
    unsigned* ctl = (unsigned*)(ws + WS_CTL);
    for (int u = (int)threadIdx.x; u < (LDS_BYTES - LDSCTL_OFF) / 4; u += NWAVES * 64) ((LAS unsigned*)(F.lds + LDSCTL_OFF))[u] = 0u;
    __syncthreads();
    if (threadIdx.x == 0) {
#pragma unroll
        for (int i = 0; i < N_IN; ++i) { const unsigned long long p_ = (unsigned long long)kargs.in[i]; ((LAS unsigned*)(F.lds + ARGTAB_OFF))[2 * i] = (unsigned)p_; ((LAS unsigned*)(F.lds + ARGTAB_OFF))[2 * i + 1] = (unsigned)(p_ >> 32); } }
    __syncthreads();
#if MK_ONE_LAUNCH
    XcdBarrier bar = xcd_barrier_post(ctl + CW_BAR, (volatile LAS unsigned*)(F.lds + MISC_OFF) + 8);
    if (threadIdx.x == 0) { const unsigned g_ = blockIdx.x & 7u, id_ = xb_xcc_id(); atomicMax(ctl + CW_GRP + 64 * g_, id_ + 1u); atomicMax(ctl + CW_GRP + 512 + 64 * g_, 16u - id_); xb_add(ctl + CW_GRP + 1024 + 64 * g_, 1u); }
    int grp_ok = 0;
#define LSEAM(k) do { if (grp_ok) { SPAN_B(100); grp_barrier(ctl + CW_TEAM + 64 * (blockIdx.x & 63u), 4u, ctl + CW_BAR); SPAN_E(100); } else SEAM(k); } while (0)
#define SEAM(k) do { if (IN(k) && IN((k) + 1)) { SPAN_B(100); SPAN_B(101 + ((k) == 0 ? 13 : ((k) - 1) % PH_PER_LAYER)); xcd_barrier(bar); SPAN_E(100); SPAN_E(101 + ((k) == 0 ? 13 : ((k) - 1) % PH_PER_LAYER)); } } while (0)
#else
#define SEAM(k) do { } while (0)
#endif
    unsigned long long pr_t0 = 0; F.pr_acc = 0; F.pr_me = (blockIdx.x == 0 && F.wave == 0);
#define SPAN_B(id) do { if (PROBE_SPAN == (id) && F.pr_me) pr_t0 = __builtin_amdgcn_s_memrealtime(); } while (0)
#define SPAN_E(id) do { if (PROBE_SPAN == (id) && F.pr_me) F.pr_acc += __builtin_amdgcn_s_memrealtime() - pr_t0; } while (0)
    const int lo = args.ph_lo, hi = args.ph_hi;
#if MK_ONE_LAUNCH
#define IN(k) true
#else
#define IN(k) (lo <= (k) && (k) < hi)
#endif
    const int gw = F.vcu * NWAVES + F.wave, NGW = F.G * NWAVES;

    SPAN_B(50); if (IN(0)) REPC(0) { p0_prologue(args, F); __syncthreads(); for (int it = F.vcu; it < DEPTH * 64; it += F.G) s5_build_item(args, F, it); }
    SPAN_E(50); SEAM(0);
#if MK_ONE_LAUNCH
    { unsigned ok_ = (gridDim.x == 256u) ? 1u : 0u;
      for (int g_ = 0; g_ < 8; ++g_) { const unsigned a_ = xb_ld(ctl + CW_GRP + 64 * g_), b_ = xb_ld(ctl + CW_GRP + 512 + 64 * g_), c_ = xb_ld(ctl + CW_GRP + 1024 + 64 * g_); if (a_ + b_ != 17u || c_ != 32u) ok_ = 0u; }
      grp_ok = __builtin_amdgcn_readfirstlane((int)ok_); }
#endif
#pragma unroll 1
    for (int l = 0; l < DEPTH; ++l) {
        const int pb = 1 + l * PH_PER_LAYER;
        { unsigned long long wsp_ = (unsigned long long)ws; asm volatile("" : "+s"(wsp_)); ws = (unsigned char*)wsp_; }
        const unsigned char* wl = ws + WS_W + (size_t)l * WL_STRIDE;
        bf16* hb = (bf16*)(ws + WS_HB); const float* cvec = (const float*)(ws + WS_CTL + CTL_CVEC) + (size_t)l * 2 * CV_N;
#define STATS(k) ((float*)(ws + WS_CTL + CTL_STATS + (size_t)(k) * STATS_BYTES))
#define STATL ((const float*)(unsigned long long)(unsigned)(unsigned long long)(F.lds + STATL_OFF))
#define TB(n) ((bf16*)(ws + (((n) & 1) ? WS_HF : WS_T)))
        SPAN_B(1); if (IN(pb + 0)) REPC(1) { pg8::StaticOrder S; S.init(M, PROJ, F.G, bid_now());
            if (l == 0) { pg8::Gemm g{hb, (const bf16*)(wl + WO_IN), M, PROJ, D}; pg8::EpiBf16Plain E{(bf16*)(ws + WS_PROJ), PROJ, (float*)(ws + WS_CTL + CTL_SGST) + (size_t)l * 2 * M}; pg8::gemm_phase<pg8::EpiBf16Plain, pg8::StaticOrder, true, true>(F.lds + RING_OFF, g, S, E); }
            else { stats_to_lds(F, STATS(3 * l - 1)); pg8::Gemm g{TB(3 * l - 1), (const bf16*)(wl + WO_IN), M, PROJ, D}; pg8::EpiLnBf16 E{(bf16*)(ws + WS_PROJ), PROJ, STATL, cvec + CV_IN, cvec + CV_N + CV_IN, (float*)(ws + WS_CTL + CTL_SGST) + (size_t)l * 2 * M}; pg8::gemm_phase<pg8::EpiLnBf16, pg8::StaticOrder, true, true>(F.lds + RING_OFF, g, S, E); } }
        SPAN_E(1); SEAM(pb + 0);
        SPAN_B(2); if (IN(pb + 1)) REPC(3) {
            const int lane = lane_now();
            SPAN_B(21); REPC(7) for (int it = gw; it < 32 * 64; it += NGW) s5_v_item(args, l, it >> 6, ((it >> 3) & 7) * 8 + (it & 7), lane);
            SPAN_E(21); SPAN_B(22);
            if (l == 0) cvec_reduce(args, gw, NGW, lane);
            SPAN_E(22); SPAN_B(23); REPC(9) hg_gate_phase(args, (unsigned char*)TB(3 * l), l, gw, NGW, lane); SPAN_E(23);
        }
        SPAN_E(2); SEAM(pb + 1);
        SPAN_B(3); if (IN(pb + 2)) REPC(5) {
            { const int lane = lane_now(); for (int it = F.vcu; it < 64 * BATCH; it += F.G) s5_scan_wg(args, F, l, it, lane); }
            for (int it = F.vcu; it < BATCH * 16 * 4; it += F.G) hg_chunk_item(args, F, (const unsigned char*)TB(3 * l), it);
        }
        SPAN_E(3); SEAM(pb + 2);
        SPAN_B(4); if (IN(pb + 3)) REPC(6) {
            { const int lane = lane_now(); REPC(10) for (int it = gw; it < 32 * 64; it += NGW) s5_y_item(args, l, it >> 6, ((it >> 3) & 7) * 8 + (it & 7), lane); }
            __syncthreads();
            sgu_phase(args, F, l);
        }
        SPAN_E(4); SEAM(pb + 3);
        SPAN_B(5); if (IN(pb + 4)) REPC(1) { pg8::Gemm g{(const bf16*)(ws + WS_Z), (const bf16*)(wl + WO_GLU), M, S5W, S5W}; pg8::StaticOrder S; S.init(M, S5W, F.G, bid_now());
            pg8::EpiGlu E{(const bf16*)(ws + WS_Z), (bf16*)(ws + WS_ZA), S5W}; pg8::gemm_phase<pg8::EpiGlu, pg8::StaticOrder, true, true>(F.lds + RING_OFF, g, S, E); }
        SPAN_E(5); LSEAM(pb + 4);
        SPAN_B(6); if (IN(pb + 5)) REPC(4) norm_phase(args, F, l);
        SPAN_E(6); LSEAM(pb + 5);
        SPAN_B(7); if (IN(pb + 6)) REPC(1) { pg8::Gemm g{(const bf16*)(ws + WS_CAT), (const bf16*)(wl + WO_OUT), M, D, D}; pg8::StaticOrder S; S.init(M, D, F.G, bid_now());
            if (l == 0) { pg8::EpiRes<true> E{args.in[I_X], (const bf16*)nullptr, (const float*)nullptr, (const float*)nullptr, (const float*)nullptr, TB(0), STATS(0), D, ALPHA}; pg8::gemm_phase<pg8::EpiRes<true>, pg8::StaticOrder, true, true>(F.lds + RING_OFF, g, S, E); }
            else { stats_to_lds(F, STATS(3 * l - 1)); pg8::EpiRes<false> E{(const float*)nullptr, TB(3 * l - 1), STATL, args.in[I_LN3W] + (l - 1) * D, args.in[I_LN3B] + (l - 1) * D, TB(3 * l), STATS(3 * l), D, ALPHA}; pg8::gemm_phase<pg8::EpiRes<false>, pg8::StaticOrder, true, true>(F.lds + RING_OFF, g, S, E); } }
        SPAN_E(7); LSEAM(pb + 6);
        SPAN_B(9); if (IN(pb + 7)) REPC(1) { stats_to_lds(F, STATS(3 * l)); { pg8::Gemm g{TB(3 * l), (const bf16*)(wl + WO_FI), M, 2 * DFF, D}; pg8::StaticOrder S; S.init(M, 2 * DFF, F.G, bid_now());
              pg8::EpiSwiGLU E{(bf16*)(ws + WS_MID), DFF, STATL, cvec + CV_FI, cvec + CV_N + CV_FI}; pg8::gemm_phase<pg8::EpiSwiGLU, pg8::StaticOrder, true, true>(F.lds + RING_OFF, g, S, E); }
            int Gq = F.G; asm volatile("" : "+s"(Gq));
            const int nfull = ((M / 256) * (2 * DFF / 256)) % Gq;
            const int nshort = Gq - nfull, cs = bid_now() - nfull;
            if (cs >= 0) { int kple = PLE; asm volatile("" : "+s"(kple));
              pg8::Gemm g{(const bf16*)(ws + WS_PB) + (size_t)l * M * PLE, (const bf16*)(wl + WO_PI), M, D, kple}; pg8::StaticOrder S; S.init(M, D, nshort, cs);
              pg8::EpiBf16Plain E{(bf16*)(ws + WS_CAT), D, (float*)nullptr}; pg8::gemm_phase<pg8::EpiBf16Plain, pg8::StaticOrder, true, true>(F.lds + RING_OFF, g, S, E); } }
        SPAN_E(9); LSEAM(pb + 7);
        SPAN_B(10); if (IN(pb + 8)) REPC(1) { stats_to_lds(F, STATS(3 * l)); pg8::Gemm g{(const bf16*)(ws + WS_MID), (const bf16*)(wl + WO_FO), M, D, DFF}; pg8::StaticOrder S; S.init(M, D, F.G, bid_now());
            pg8::EpiRes<false> E{(const float*)nullptr, TB(3 * l), STATL, args.in[I_LN1W] + l * D, args.in[I_LN1B] + l * D, TB(3 * l + 1), STATS(3 * l + 1), D, ALPHA}; pg8::gemm_phase<pg8::EpiRes<false>, pg8::StaticOrder, true, true>(F.lds + RING_OFF, g, S, E); }
        SPAN_E(10); LSEAM(pb + 8);
        SPAN_B(12); if (IN(pb + 9)) REPC(1) { stats_to_lds(F, STATS(3 * l + 1)); pg8::Gemm g{TB(3 * l + 1), (const bf16*)(wl + WO_PG), M, D, D}; pg8::StaticOrder S; S.init(M, D, F.G, bid_now());
            pg8::EpiPle E{TB(3 * l + 1), STATL, args.in[I_LN2W] + l * D, args.in[I_LN2B] + l * D, cvec + CV_PG, cvec + CV_N + CV_PG, (const bf16*)(ws + WS_CAT), TB(3 * l + 2), STATS(3 * l + 2), D, ALPHA};
            pg8::gemm_phase<pg8::EpiPle, pg8::StaticOrder, true, true>(F.lds + RING_OFF, g, S, E); }
        SPAN_E(12);
        if (PROBE_SPAN != 0 && l == DEPTH - 1 && F.pr_me) { const unsigned long long t0_ = __builtin_amdgcn_s_memrealtime(); while (__builtin_amdgcn_s_memrealtime() - t0_ < 8ull * F.pr_acc) __builtin_amdgcn_s_sleep(8); }
        if (l == DEPTH - 1) SEAM(pb + 9); else LSEAM(pb + 9);
    }
    { const int pl = 1 + DEPTH * PH_PER_LAYER; SPAN_B(13); if (IN(pl)) REPC(2) ln_phase(F, (const bf16*)(ws + (((3 * DEPTH - 1) & 1) ? WS_HF : WS_T)), args.in[I_LN3W] + (DEPTH - 1) * D, args.in[I_LN3B] + (DEPTH - 1) * D, args.out, (bf16*)nullptr, (float*)nullptr); SPAN_E(13); }
#undef IN
#undef SEAM
#undef TB
#undef STATS
#undef STATL
    (void)gw; (void)NGW; (void)ctl; (void)lo; (void)hi;
}

extern "C" void kernel_launch(void* const* d_in, const int* in_sizes, int n_in, void* d_out, int out_size, void* d_ws, size_t ws_size, hipStream_t stream) {
    static int grid = 0;
    if (grid == 0) {
        if (n_in != N_IN || in_sizes[0] != M * D || out_size != M * D || ws_size < WS_END2) { fprintf(stderr, "kernel_launch: unexpected shapes: n_in %d in0 %d out %d ws %zu (need %zu)\n", n_in, n_in > 0 ? in_sizes[0] : -1, out_size, ws_size, (size_t)WS_END2); grid = -1; return; }
        int dev = 0, cus = 0, per_cu = 0;
        if (hipGetDevice(&dev) != hipSuccess || hipDeviceGetAttribute(&cus, hipDeviceAttributeMultiprocessorCount, dev) != hipSuccess) { grid = -1; return; }
        if (hipFuncSetAttribute((const void*)mega_fwd, hipFuncAttributeMaxDynamicSharedMemorySize, LDS_BYTES) != hipSuccess) { fprintf(stderr, "kernel_launch: hipFuncSetAttribute failed\n"); grid = -1; return; }
        if (hipOccupancyMaxActiveBlocksPerMultiprocessor(&per_cu, (const void*)mega_fwd, NWAVES * 64, LDS_BYTES) != hipSuccess || per_cu < 1) fprintf(stderr, "kernel_launch: occupancy query says %d\n", per_cu);
        (void)hipGetLastError();
        grid = cus;
    }
    if (grid < 0) return;
    (void)hipMemsetAsync((char*)d_ws + WS_CTL, 0, CTL_ZERO_BYTES, stream);
    KArgs a{};
    for (int i = 0; i < N_IN; ++i) a.in[i] = (const float*)d_in[i];
    a.out = (float*)d_out; a.ws = (unsigned char*)d_ws; a.rep = 0x111111111111ull; for (int c = 0; c < 12; ++c) if ((PROBE_REP >> c) & 1) a.rep += 1ull << (4 * c);
#if MK_ONE_LAUNCH
    a.ph_lo = 0; a.ph_hi = N_PHASES;
    hipLaunchKernelGGL(mega_fwd, dim3(grid), dim3(NWAVES * 64), LDS_BYTES, stream, a);
#else
    for (int p = 0; p < N_PHASES; ++p) { a.ph_lo = p; a.ph_hi = p + 1; hipLaunchKernelGGL(mega_fwd, dim3(grid), dim3(NWAVES * 64), LDS_BYTES, stream, a); }
#endif
}
```
